# Optimizing an MI355X kernel written in HIP

```python
import math
import jax
import jax.numpy as jnp
from jax import lax
import numpy as np

D_MODEL = 4096
BATCH = 1
SEQ = 16384
DEPTH = 1

GRID_W = 64
CTX_LEN = 256
DA_HEADS = 16
DA_QK_DIM = 64
DA_V_DIM = 2 * DA_QK_DIM
DA_WIDTH = DA_HEADS * DA_V_DIM
WA_Q_HEADS = 16
WA_KV_HEADS = 4
WA_GROUP = WA_Q_HEADS // WA_KV_HEADS
WA_HEAD_DIM = 128
WA_WIDTH = WA_Q_HEADS * WA_HEAD_DIM
WINDOW = 128
BLOCK = 128
N_BRANCH = 2
D_FF = 11008
CONV_W = 3
ROPE_BASE = 10000.0
EPS = 1e-6
DA_SCALE = DA_QK_DIM ** -0.5
WA_SCALE = WA_HEAD_DIM ** -0.5
NEG_INF = -1e30
OFF_KA = DA_HEADS * 2 * DA_QK_DIM
OFF_VA = OFF_KA + DA_HEADS * 2 * DA_QK_DIM
OFF_QW = OFF_VA + DA_WIDTH
OFF_KW = OFF_QW + WA_WIDTH
OFF_VW = OFF_KW + WA_KV_HEADS * WA_HEAD_DIM
OFF_GATE = OFF_VW + WA_KV_HEADS * WA_HEAD_DIM
IN_WIDTH = OFF_GATE + N_BRANCH * D_MODEL

kernel_name = "hybrid_diffattn_windowgqa_convffn_dit"


def _rms(x, g):
    xf = x.astype(jnp.float32)
    y = xf * lax.rsqrt(jnp.mean(xf * xf, axis=-1, keepdims=True) + EPS)
    return (y * g.astype(jnp.float32)).astype(x.dtype)


def _adaln(cvec, w, b):
    m = jax.nn.silu(cvec) @ w + b
    return jnp.split(m, 6, axis=-1)


def _modulate(x, shift, scale):
    return x * (1.0 + scale[:, None, :]) + shift[:, None, :]


def _axial_rope_tables(rows, head_dim):
    r = jnp.repeat(jnp.arange(rows, dtype=jnp.float32), GRID_W)
    col = jnp.tile(jnp.arange(GRID_W, dtype=jnp.float32), rows)
    axis_dim = head_dim // 2
    freq = ROPE_BASE ** (-jnp.arange(0, axis_dim, 2, dtype=jnp.float32) / axis_dim)
    ar = r[:, None] * freq
    ac = col[:, None] * freq
    return (jnp.cos(ar), jnp.sin(ar), jnp.cos(ac), jnp.sin(ac))


def _rotate(x, cos, sin):
    x1, x2 = jnp.split(x, 2, axis=-1)
    cos = cos[None, :, None, :].astype(x.dtype)
    sin = sin[None, :, None, :].astype(x.dtype)
    return jnp.concatenate([x1 * cos - x2 * sin, x2 * cos + x1 * sin], axis=-1)


def _rope2d(x, tabs):
    cr, sr, cc, sc = tabs
    half = x.shape[-1] // 2
    return jnp.concatenate([_rotate(x[..., :half], cr, sr), _rotate(x[..., half:], cc, sc)], axis=-1)


def _qk_heads(t, n_heads, dim, g, tabs):
    B, n = t.shape[:2]
    t = _rms(t.reshape(B, n, n_heads, dim), g)
    if tabs is not None:
        t = _rope2d(t, tabs)
    return t


def _diff_attend(q, k, v, lam, lam_init, subln_g):
    s = jnp.einsum('bqhmd,bkhmd->bhmqk', q, k).astype(jnp.float32) * DA_SCALE
    p = jax.nn.softmax(s, axis=-1)
    a = p[:, :, 0] - lam * p[:, :, 1]
    o = jnp.einsum('bhqk,bkhd->bqhd', a.astype(v.dtype), v)
    return _rms(o, subln_g) * (1.0 - lam_init)


def _latent_diff_attention(q, k_all, v_all, lam, lam_init, subln_g):
    B, S = q.shape[:2]
    nb = S // BLOCK
    qb = jnp.moveaxis(q.reshape(B, nb, BLOCK, DA_HEADS, 2, DA_QK_DIM), 1, 0)
    o = lax.map(lambda qq: _diff_attend(qq, k_all, v_all, lam, lam_init, subln_g), qb)
    return jnp.moveaxis(o, 0, 1).reshape(B, S, DA_WIDTH)


def _sink_attend(q, k, v, sink, valid):
    s = jnp.einsum('bqgrd,bkgd->bgrqk', q, k).astype(jnp.float32) * WA_SCALE
    s = jnp.where(valid, s, NEG_INF)
    sink_col = jnp.broadcast_to(
        sink.reshape(WA_KV_HEADS, WA_GROUP)[None, :, :, None, None].astype(jnp.float32),
        s.shape[:-1] + (1,))
    p = jax.nn.softmax(jnp.concatenate([s, sink_col], axis=-1), axis=-1)[..., :-1]
    return jnp.einsum('bgrqk,bkgd->bqgrd', p.astype(v.dtype), v)


def _latent_window_attention(q, k, v, k_ctx, v_ctx, sink):
    B, S = q.shape[:2]
    C = k_ctx.shape[1]
    nb = S // BLOCK
    band = 3 * BLOCK
    qb = jnp.moveaxis(q.reshape(B, nb, BLOCK, WA_KV_HEADS, WA_GROUP, WA_HEAD_DIM), 1, 0)
    pad = ((0, 0), (BLOCK, BLOCK), (0, 0), (0, 0))
    kp = jnp.pad(k, pad)
    vp = jnp.pad(v, pad)
    ctx_ok = jnp.ones((BLOCK, C), dtype=bool)

    def one_block(args):
        i, qq = args
        start = i * BLOCK
        kb = jnp.concatenate([lax.dynamic_slice_in_dim(kp, start, band, axis=1), k_ctx], axis=1)
        vb = jnp.concatenate([lax.dynamic_slice_in_dim(vp, start, band, axis=1), v_ctx], axis=1)
        q_pos = start + jnp.arange(BLOCK)
        k_pos = start - BLOCK + jnp.arange(band)
        near = ((jnp.abs(q_pos[:, None] - k_pos[None, :]) <= WINDOW)
                & (k_pos[None, :] >= 0) & (k_pos[None, :] < S))
        valid = jnp.concatenate([near, ctx_ok], axis=1)
        return _sink_attend(qq, kb, vb, sink, valid)

    o = lax.map(one_block, (jnp.arange(nb), qb))
    return jnp.moveaxis(o, 0, 1).reshape(B, S, WA_WIDTH)


def _merge(y_da, y_wa, gate_logits, b_gate, w_o_da, w_o_wa, w_out):
    g_da, g_wa = jnp.split(jax.nn.sigmoid(gate_logits + b_gate), N_BRANCH, axis=-1)
    return (g_da * (y_da @ w_o_da) + g_wa * (y_wa @ w_o_wa)) @ w_out


def _conv_ffn(h, w_up, conv_w, conv_b, w_down):
    a, u = jnp.split(h @ w_up, 2, axis=-1)
    n = a.shape[1]
    pad = CONV_W // 2
    ap = jnp.pad(a, ((0, 0), (pad, pad), (0, 0)))
    conv = conv_b
    for j in range(CONV_W):
        conv = conv + ap[:, j:j + n] * conv_w[j]
    return (jax.nn.silu(conv) * u) @ w_down


def setup_inputs(seed: int = 0) -> dict:
    key = jax.random.key(seed)
    ks = jax.random.split(key, 27)
    f32 = jnp.float32
    L, D = DEPTH, D_MODEL

    def nrm(k, shape, scale):
        return jax.random.normal(k, shape, f32) * scale

    return {
        "x": nrm(ks[0], (BATCH, SEQ, D), 1.0),
        "c": nrm(ks[1], (BATCH, D), 1.0),
        "ctx": nrm(ks[2], (BATCH, CTX_LEN, D), 1.0),
        "c_ctx": nrm(ks[3], (D,), 1.0),
        "w_ada": nrm(ks[4], (L, D, 6 * D), 0.5 * D ** -0.5),
        "b_ada": nrm(ks[5], (L, 6 * D), 0.02),
        "attn_norm_g": 1.0 + nrm(ks[6], (L, D), 0.02),
        "w_in": nrm(ks[7], (L, D, IN_WIDTH), D ** -0.5),
        "b_gate": nrm(ks[8], (L, N_BRANCH * D), 0.02),
        "da_qn_g": 1.0 + nrm(ks[9], (L, DA_QK_DIM), 0.02),
        "da_kn_g": 1.0 + nrm(ks[10], (L, DA_QK_DIM), 0.02),
        "da_lambda_q1": nrm(ks[11], (L, DA_QK_DIM), 0.1),
        "da_lambda_k1": nrm(ks[12], (L, DA_QK_DIM), 0.1),
        "da_lambda_q2": nrm(ks[13], (L, DA_QK_DIM), 0.1),
        "da_lambda_k2": nrm(ks[14], (L, DA_QK_DIM), 0.1),
        "da_subln_g": 1.0 + nrm(ks[15], (L, DA_V_DIM), 0.02),
        "wa_qn_g": 1.0 + nrm(ks[16], (L, WA_HEAD_DIM), 0.02),
        "wa_kn_g": 1.0 + nrm(ks[17], (L, WA_HEAD_DIM), 0.02),
        "wa_sink": nrm(ks[18], (L, WA_Q_HEADS), 0.5),
        "w_o_da": nrm(ks[19], (L, DA_WIDTH, D), DA_WIDTH ** -0.5),
        "w_o_wa": nrm(ks[20], (L, WA_WIDTH, D), WA_WIDTH ** -0.5),
        "w_out": nrm(ks[21], (L, D, D), D ** -0.5),
        "ffn_norm_g": 1.0 + nrm(ks[22], (L, D), 0.02),
        "w_ffn_up": nrm(ks[23], (L, D, 2 * D_FF), D ** -0.5),
        "ffn_conv_w": nrm(ks[24], (L, CONV_W, D_FF), 0.5),
        "ffn_conv_b": nrm(ks[25], (L, D_FF), 0.02),
        "w_ffn_down": nrm(ks[26], (L, D_FF, D), D_FF ** -0.5),
    }


def reference(x, c, ctx, c_ctx, w_ada, b_ada, attn_norm_g, w_in, b_gate,
              da_qn_g, da_kn_g, da_lambda_q1, da_lambda_k1, da_lambda_q2, da_lambda_k2,
              da_subln_g, wa_qn_g, wa_kn_g, wa_sink, w_o_da, w_o_wa, w_out,
              ffn_norm_g, w_ffn_up, ffn_conv_w, ffn_conv_b, w_ffn_down):
    B, S, _ = x.shape
    C = ctx.shape[1]
    ROWS = S // GRID_W
    tabs_da = _axial_rope_tables(ROWS, DA_QK_DIM)
    tabs_wa = _axial_rope_tables(ROWS, WA_HEAD_DIM)

    for l in range(DEPTH):
        last = l == DEPTH - 1
        wl = w_in[l]
        lam_init = 0.8 - 0.6 * math.exp(-0.3 * l)
        lam = (jnp.exp(jnp.sum(da_lambda_q1[l] * da_lambda_k1[l]).astype(jnp.float32))
               - jnp.exp(jnp.sum(da_lambda_q2[l] * da_lambda_k2[l]).astype(jnp.float32))
               + lam_init)
        sh1, sc1, g1, sh2, sc2, g2 = _adaln(c, w_ada[l], b_ada[l])
        csh1, csc1, cg1, csh2, csc2, cg2 = _adaln(c_ctx[None, :], w_ada[l], b_ada[l])

        h = _modulate(_rms(x, attn_norm_g[l]), sh1, sc1)
        hc = _modulate(_rms(ctx, attn_norm_g[l]), csh1, csc1)

        pr = h @ wl
        qa, ka, va = pr[..., :OFF_KA], pr[..., OFF_KA:OFF_VA], pr[..., OFF_VA:OFF_QW]
        qw, kw, vw = pr[..., OFF_QW:OFF_KW], pr[..., OFF_KW:OFF_VW], pr[..., OFF_VW:OFF_GATE]
        gates = pr[..., OFF_GATE:]
        kva_c = hc @ wl[:, OFF_KA:OFF_QW]
        kvw_c = hc @ wl[:, OFF_KW:OFF_GATE]
        ka_c, va_c = kva_c[..., :OFF_VA - OFF_KA], kva_c[..., OFF_VA - OFF_KA:]
        kw_c, vw_c = kvw_c[..., :OFF_VW - OFF_KW], kvw_c[..., OFF_VW - OFF_KW:]

        q_da = _qk_heads(qa, 2 * DA_HEADS, DA_QK_DIM, da_qn_g[l], tabs_da).reshape(B, S, DA_HEADS, 2, DA_QK_DIM)
        k_da = _qk_heads(ka, 2 * DA_HEADS, DA_QK_DIM, da_kn_g[l], tabs_da).reshape(B, S, DA_HEADS, 2, DA_QK_DIM)
        v_da = va.reshape(B, S, DA_HEADS, DA_V_DIM)
        kc_da = _qk_heads(ka_c, 2 * DA_HEADS, DA_QK_DIM, da_kn_g[l], None).reshape(B, C, DA_HEADS, 2, DA_QK_DIM)
        vc_da = va_c.reshape(B, C, DA_HEADS, DA_V_DIM)
        k_all = jnp.concatenate([k_da, kc_da], axis=1)
        v_all = jnp.concatenate([v_da, vc_da], axis=1)
        y_da = _latent_diff_attention(q_da, k_all, v_all, lam, lam_init, da_subln_g[l])

        q_wa = _qk_heads(qw, WA_Q_HEADS, WA_HEAD_DIM, wa_qn_g[l], tabs_wa).reshape(B, S, WA_KV_HEADS, WA_GROUP, WA_HEAD_DIM)
        k_wa = _qk_heads(kw, WA_KV_HEADS, WA_HEAD_DIM, wa_kn_g[l], tabs_wa)
        v_wa = vw.reshape(B, S, WA_KV_HEADS, WA_HEAD_DIM)
        kc_wa = _qk_heads(kw_c, WA_KV_HEADS, WA_HEAD_DIM, wa_kn_g[l], None)
        vc_wa = vw_c.reshape(B, C, WA_KV_HEADS, WA_HEAD_DIM)
        y_wa = _latent_window_attention(q_wa, k_wa, v_wa, kc_wa, vc_wa, wa_sink[l])

        mix = _merge(y_da, y_wa, gates, b_gate[l], w_o_da[l], w_o_wa[l], w_out[l])

        if not last:
            qc_da = _qk_heads(hc @ wl[:, :OFF_KA], 2 * DA_HEADS, DA_QK_DIM, da_qn_g[l], None).reshape(B, C, DA_HEADS, 2, DA_QK_DIM)
            yc_da = _diff_attend(qc_da, kc_da, vc_da, lam, lam_init, da_subln_g[l]).reshape(B, C, DA_WIDTH)
            qc_wa = _qk_heads(hc @ wl[:, OFF_QW:OFF_KW], WA_Q_HEADS, WA_HEAD_DIM, wa_qn_g[l], None).reshape(B, C, WA_KV_HEADS, WA_GROUP, WA_HEAD_DIM)
            yc_wa = _sink_attend(qc_wa, kc_wa, vc_wa, wa_sink[l], jnp.ones((C, C), dtype=bool)).reshape(B, C, WA_WIDTH)
            mixc = _merge(yc_da, yc_wa, hc @ wl[:, OFF_GATE:], b_gate[l], w_o_da[l], w_o_wa[l], w_out[l])
            ctx = ctx + cg1[:, None, :] * mixc
            hc2 = _modulate(_rms(ctx, ffn_norm_g[l]), csh2, csc2)
            ctx = ctx + cg2[:, None, :] * _conv_ffn(hc2, w_ffn_up[l], ffn_conv_w[l], ffn_conv_b[l], w_ffn_down[l])

        x = x + g1[:, None, :] * mix

        h2 = _modulate(_rms(x, ffn_norm_g[l]), sh2, sc2)
        x = x + g2[:, None, :] * _conv_ffn(h2, w_ffn_up[l], ffn_conv_w[l], ffn_conv_b[l], w_ffn_down[l])

    return x
```

```cpp
#include <hip/hip_runtime.h>
#include <cstdio>
#include <cstdint>

#define GAS __attribute__((address_space(1)))
#define LAS __attribute__((address_space(3)))

typedef unsigned short bf16_t;
typedef short bf16x8 __attribute__((ext_vector_type(8)));
typedef short s16x4 __attribute__((ext_vector_type(4)));
typedef float f32x4 __attribute__((ext_vector_type(4)));
typedef float f32x2 __attribute__((ext_vector_type(2)));
typedef float f32x16 __attribute__((ext_vector_type(16)));
typedef unsigned u32x4 __attribute__((ext_vector_type(4)));
typedef unsigned u32x2 __attribute__((ext_vector_type(2)));

constexpr int DM = 4096, SEQ = 16384, CTX = 256, MR = SEQ + CTX;
constexpr int NIN = 17408, NQKV = 9216, NGATE = 8192, DFF = 11008, NUP = 22016, NADA = 24576;
constexpr int OFF_KA = 2048, OFF_VA = 4096, OFF_QW = 6144, OFF_KW = 8192, OFF_VW = 8704;
constexpr float EPS = 1e-6f;
constexpr float LOG2E = 1.4426950408889634f;
constexpr float DA_C = 0.125f * LOG2E;
constexpr float WA_C = 0.08838834764831845f * LOG2E;
constexpr int NWAVES = 8;

constexpr size_t MiB = 1u << 20;
constexpr size_t WS_CTL = 0, CTL_ZERO_BYTES = 32768;
constexpr size_t WS_PART = 1 * MiB;
constexpr size_t WS_PARTC = WS_PART + (size_t)16 * NADA * 4;
constexpr size_t WS_VEC = 3 * MiB;
constexpr size_t WS_ROPE_DA = WS_VEC + 8 * 4096 * 4;
constexpr size_t WS_ROPE_WA = WS_ROPE_DA + 2 * 256 * 16 * 4;
constexpr size_t WS_WUP = 4 * MiB;
constexpr size_t WS_WDN = 176 * MiB;
constexpr size_t WS_WOUT = 262 * MiB;
constexpr size_t WS_WODA = 294 * MiB;
constexpr size_t WS_WOWA = 310 * MiB;
constexpr size_t WS_WIN = 326 * MiB;
constexpr size_t WS_H = 462 * MiB;
constexpr size_t WS_QKV = 592 * MiB;
constexpr size_t WS_GATES = 885 * MiB;
constexpr size_t WS_O01 = 1145 * MiB;
constexpr size_t WS_YDA = 1401 * MiB;
constexpr size_t WS_YWA = 1465 * MiB;
constexpr size_t WS_END = 1529 * MiB;
constexpr size_t WS_T = WS_QKV;
constexpr size_t WS_H2 = WS_WOUT;
constexpr size_t WS_A = 390 * MiB;
constexpr size_t WS_U = 734 * MiB;
constexpr size_t WS_HID = 1078 * MiB;
constexpr size_t WS_EDGE = 400 * MiB;
constexpr size_t EDGE_ELEMS = (size_t)64 * 2 * DFF;
static_assert(WS_WIN + (size_t)NIN * DM * 2 <= WS_H && WS_H + (size_t)MR * DM * 2 <= WS_QKV && WS_QKV + (size_t)MR * NQKV * 2 <= WS_GATES, "ws map 1");
static_assert(WS_GATES + (size_t)MR * NGATE * 2 <= WS_O01 && WS_O01 + (size_t)2 * SEQ * 2048 * 4 <= WS_YDA && WS_HID + (size_t)SEQ * DFF * 2 <= WS_END, "ws map 2");
static_assert(WS_H2 + (size_t)SEQ * DM * 2 <= WS_A && WS_A + (size_t)SEQ * DFF * 2 <= WS_U && WS_U + (size_t)SEQ * DFF * 2 <= WS_HID, "ws map 3");
static_assert(WS_ROPE_WA + 2 * 256 * 32 * 4 <= WS_WUP, "ws map 0");
constexpr int CW_BAR = 4096;

constexpr int RING_BYTES = 131072;
constexpr int LDSCTL_OFF = RING_BYTES, MISC_OFF = LDSCTL_OFF + 320;
constexpr int LDS_BYTES = 147456;
constexpr int EDGE_OFF = LDSCTL_OFF + 1024;

#define LDS_WAIT() asm volatile("s_waitcnt lgkmcnt(0)" ::: "memory")
#define VM_WAIT() asm volatile("s_waitcnt vmcnt(0)" ::: "memory")

typedef __bf16 bf16x2_t __attribute__((ext_vector_type(2)));
__device__ __forceinline__ unsigned cvt_pk_bf16(float lo, float hi) { const f32x2 v = {lo, hi}; const bf16x2_t b = __builtin_convertvector(v, bf16x2_t); return __builtin_bit_cast(unsigned, b); }
__device__ __forceinline__ float bf_lo(unsigned w) { return __uint_as_float(w << 16); }
__device__ __forceinline__ float bf_hi(unsigned w) { return __uint_as_float(w & 0xffff0000u); }
__device__ __forceinline__ float shx(float v, int m, int lane) { return __uint_as_float((unsigned)__builtin_amdgcn_ds_bpermute((lane ^ m) << 2, (int)__float_as_uint(v))); }
__device__ __forceinline__ float wave_sum(float v, int lane) {
#pragma unroll
    for (int o = 1; o < 64; o <<= 1) v += shx(v, o, lane);
    return v;
}
__device__ __forceinline__ int opq(int v) { asm volatile("" : "+v"(v)); return v; }
__device__ __forceinline__ float silu_f(float x) { return x / (1.0f + __expf(-x)); }
__device__ __forceinline__ float sigmoid_f(float x) { return __builtin_amdgcn_rcpf(1.0f + __builtin_amdgcn_exp2f(-x * LOG2E)); }

namespace pg8 {
#define PG8_LAS __attribute__((address_space(3)))
constexpr int BM = 256, BK = 64, HALF = 128, HTB = HALF * BK * 2, STAGE_BYTES = 8 * HTB, NXCD = 8, WGM = 8;
__host__ __device__ __forceinline__ int lds_byte(int r, int c) { const int st = (r >> 4) * 2 + (c >> 5), rr = r & 15, cc = c & 31, ob = rr * 64 + cc * 2; return st * 1024 + (ob ^ (((ob >> 9) & 1) << 5)); }
__host__ __device__ __forceinline__ void stage_rc(int b, int& R, int& C) { const int st = b / 1024, sb = b % 1024, swz = sb ^ (((sb >> 9) & 1) << 5); R = (st >> 1) * 16 + swz / 64; C = (st & 1) * 32 + (swz % 64) / 2; }
__host__ __device__ __forceinline__ int perm32(int rho) { const int n = rho >> 4, i = rho & 15; return 8 * (i >> 2) + 4 * n + (i & 3); }
struct Unit { int pm, pn; };
struct Gemm { const bf16_t* A; const bf16_t* Bt; int M, N, K; };
struct StaticOrder {
    int nM, nN, nwg, G, c, wgm;
    __host__ __device__ void init(int M, int N, int G_, int c_, int wgm_ = WGM) { nM = M / BM; nN = N / BM; nwg = nM * nN; G = G_; c = c_; wgm = wgm_; }
    __host__ __device__ bool next(int i, Unit& u) const {
        const long L = (long)i * G + c; if (L >= nwg) return false;
        int wgid = (int)L; { const int q = nwg / NXCD, r = nwg % NXCD, xcd = wgid % NXCD, off = wgid / NXCD; wgid = (xcd < r ? xcd * (q + 1) : r * (q + 1) + (xcd - r) * q) + off; }
        const int nig = wgm * nN, gid = wgid / nig, fm = gid * wgm, gsz = (nM - fm) < wgm ? (nM - fm) : wgm;
        u.pm = fm + ((wgid % nig) % gsz); u.pn = (wgid % nig) / gsz; return true;
    }
    __device__ __forceinline__ void a_ready(const Unit&) const {}
    __device__ __forceinline__ void done(const Unit&) const {}
};

struct SingleOrder {
    int pm, pn;
    __device__ __forceinline__ bool next(int i, Unit& u) const { if (i != 0) return false; u.pm = pm; u.pn = pn; return true; }
    __device__ __forceinline__ void a_ready(const Unit&) const {}
    __device__ __forceinline__ void done(const Unit&) const {}
};
template <class Epi, class Sched, bool ALIGN_EPI = false, bool SP2 = false>
__device__ __forceinline__ void gemm_phase(PG8_LAS unsigned char* lds, const Gemm g, const Sched& S, const Epi& E) {
    const int tid = opq(threadIdx.x), wid = __builtin_amdgcn_readfirstlane(tid >> 6), lane = tid & 63, wr = wid >> 2, wc = wid & 3, fr = lane & 15, fq = lane >> 4;
    const int K = g.K, nt = K / BK;
    unsigned voffA[2], voffB[2];
#pragma unroll
    for (int i = 0; i < 2; ++i) { int R, C; stage_rc(tid * 16 + i * 8192, R, C); const int Rb = Epi::PERM ? ((R & ~31) + perm32(R & 31)) : R;
        voffA[i] = (unsigned)(R * K + C) * 2u; voffB[i] = (unsigned)(Rb * K + C) * 2u; }
    const size_t kstep = (size_t)(BK * 2);
    const size_t hstep = (size_t)HALF * K * 2;
    const size_t tstep = 2 * hstep;
    const unsigned ldsw = (unsigned)wid * 1024u;
    const int aoff = lds_byte(wr * 64 + fr, fq * 8), boff = lds_byte(wc * 32 + fr, fq * 8);
#define PG8_SA(b, h) (((b) * 2 + (h)) * HTB)
#define PG8_SB(b, h) ((4 + (b) * 2 + (h)) * HTB)
#define PG8_STAGE(bufoff, gbase, voff) do { _Pragma("unroll") for (int _i = 0; _i < 2; ++_i) \
        __builtin_amdgcn_global_load_lds((const unsigned*)((const char*)(gbase) + (voff)[_i]), (PG8_LAS unsigned*)(lds + (bufoff) + ldsw + _i * 8192), 16, 0, 0); } while (0)
#define PG8_LDA(dst, b, h) do { _Pragma("unroll") for (int m = 0; m < 4; ++m) _Pragma("unroll") for (int k = 0; k < 2; ++k) dst[m][k] = *(const PG8_LAS bf16x8*)(lds + PG8_SA(b, h) + aoff + m * 2048 + k * 1024); } while (0)
#define PG8_LDB(dst, b, h) do { _Pragma("unroll") for (int n = 0; n < 2; ++n) _Pragma("unroll") for (int k = 0; k < 2; ++k) dst[n][k] = *(const PG8_LAS bf16x8*)(lds + PG8_SB(b, h) + boff + n * 2048 + k * 1024); } while (0)
#define PG8_MMA(ai, bj, At, Bt) do { __builtin_amdgcn_s_setprio(1); _Pragma("unroll") for (int m = 0; m < 4; ++m) _Pragma("unroll") for (int n = 0; n < 2; ++n) _Pragma("unroll") for (int k = 0; k < 2; ++k) \
        acc[ai][bj][m][n] = __builtin_amdgcn_mfma_f32_16x16x32_bf16(Bt[n][k], At[m][k], acc[ai][bj][m][n], 0, 0, 0); __builtin_amdgcn_s_setprio(0); } while (0)
#define PG8_WAIT_V(n) asm volatile("s_waitcnt vmcnt(" #n ")" ::: "memory")
#define PG8_WAIT_L(n) asm volatile("s_waitcnt lgkmcnt(" #n ")" ::: "memory")
#define PG8_BAR __builtin_amdgcn_s_barrier()
#define PG8_SCHED __builtin_amdgcn_sched_barrier(0)
    Unit cur, nxt; int ui = 0;
    if (!S.next(0, cur)) return;
    f32x4 acc[2][2][4][2];
#pragma unroll
    for (int a = 0; a < 2; ++a)
#pragma unroll
        for (int b = 0; b < 2; ++b)
#pragma unroll
            for (int m = 0; m < 4; ++m)
#pragma unroll
                for (int n = 0; n < 2; ++n) acc[a][b][m][n] = (f32x4){0.f, 0.f, 0.f, 0.f};
    bf16x8 At[4][2], B0[2][2], B1[2][2];
    const char* cA = (const char*)g.A + (size_t)cur.pm * tstep; const char* cB = (const char*)g.Bt + (size_t)cur.pn * tstep;
    S.a_ready(cur);
    if constexpr (SP2) {
        PG8_STAGE(PG8_SB(0, 0), cB, voffB); PG8_STAGE(PG8_SB(0, 1), cB + hstep, voffB); PG8_STAGE(PG8_SA(0, 0), cA, voffA); PG8_STAGE(PG8_SA(0, 1), cA + hstep, voffA);
        if (wr == 1) PG8_BAR;
        PG8_WAIT_V(2); PG8_BAR;
        PG8_STAGE(PG8_SB(1, 0), cB + kstep, voffB); PG8_STAGE(PG8_SA(1, 0), cA + kstep, voffA); PG8_STAGE(PG8_SB(1, 1), cB + hstep + kstep, voffB);
        PG8_WAIT_V(6); PG8_BAR;
    } else {
        PG8_STAGE(PG8_SB(0, 0), cB, voffB); PG8_STAGE(PG8_SA(0, 0), cA, voffA); PG8_STAGE(PG8_SB(0, 1), cB + hstep, voffB); PG8_STAGE(PG8_SA(0, 1), cA + hstep, voffA);
        if (wr == 1) PG8_BAR;
        PG8_WAIT_V(4); PG8_BAR;
        PG8_STAGE(PG8_SB(1, 0), cB + kstep, voffB); PG8_STAGE(PG8_SA(1, 0), cA + kstep, voffA); PG8_STAGE(PG8_SB(1, 1), cB + hstep + kstep, voffB);
        PG8_WAIT_V(6); PG8_BAR;
    }
    for (;;) {
        const bool has_next = S.next(ui + 1, nxt);
        const char* nA = has_next ? (const char*)g.A + (size_t)nxt.pm * tstep : cA; const char* nB = has_next ? (const char*)g.Bt + (size_t)nxt.pn * tstep : cB;
        for (int t = 0; t < nt; t += 2) {
            const bool last = (t == nt - 2);
            const char* a1 = cA + (size_t)(t + 1) * kstep;
            const char* a2 = last ? nA : cA + (size_t)(t + 2) * kstep; const char* b2 = last ? nB : cB + (size_t)(t + 2) * kstep;
            const char* a3 = a2 + kstep; const char* b3 = b2 + kstep;
            if (last && has_next) S.a_ready(nxt);
            if constexpr (Epi::HAS_MID) { if (t == E.mid_t) E.mid(acc, cur, wr, wc, fr, fq); }
            if constexpr (SP2) {
            PG8_LDB(B0, 0, 0); PG8_LDB(B1, 0, 1); PG8_SCHED; PG8_LDA(At, 0, 0); PG8_STAGE(PG8_SA(1, 1), a1 + hstep, voffA);
            PG8_WAIT_V(8); PG8_WAIT_L(0); PG8_BAR; PG8_MMA(0, 0, At, B0); PG8_MMA(0, 1, At, B1); PG8_BAR; PG8_SCHED;
            PG8_LDA(At, 0, 1); PG8_STAGE(PG8_SB(0, 0), b2, voffB); PG8_STAGE(PG8_SB(0, 1), b2 + hstep, voffB); PG8_STAGE(PG8_SA(0, 0), a2, voffA);
            PG8_WAIT_V(8); PG8_WAIT_L(0); PG8_BAR; PG8_MMA(1, 0, At, B0); PG8_MMA(1, 1, At, B1); PG8_BAR; PG8_SCHED;
            PG8_LDB(B0, 1, 0); PG8_LDB(B1, 1, 1); PG8_SCHED; PG8_LDA(At, 1, 0); PG8_STAGE(PG8_SA(0, 1), a2 + hstep, voffA);
            PG8_WAIT_V(8); PG8_WAIT_L(0); PG8_BAR; PG8_MMA(0, 0, At, B0); PG8_MMA(0, 1, At, B1); PG8_BAR; PG8_SCHED;
            PG8_LDA(At, 1, 1); PG8_STAGE(PG8_SB(1, 0), b3, voffB); PG8_STAGE(PG8_SB(1, 1), b3 + hstep, voffB); PG8_STAGE(PG8_SA(1, 0), a3, voffA);
            PG8_WAIT_V(8); PG8_WAIT_L(0); PG8_BAR; PG8_MMA(1, 0, At, B0); PG8_MMA(1, 1, At, B1); PG8_BAR; PG8_SCHED;
            } else {
            PG8_LDB(B0, 0, 0); PG8_SCHED; PG8_LDA(At, 0, 0); PG8_STAGE(PG8_SA(1, 1), a1 + hstep, voffA);
            PG8_WAIT_L(8); PG8_BAR; PG8_WAIT_L(0); PG8_MMA(0, 0, At, B0); PG8_BAR; PG8_SCHED;
            PG8_LDB(B1, 0, 1); PG8_STAGE(PG8_SB(0, 0), b2, voffB);
            PG8_BAR; PG8_WAIT_L(0); PG8_MMA(0, 1, At, B1); PG8_BAR;
            PG8_LDA(At, 0, 1); PG8_STAGE(PG8_SA(0, 0), a2, voffA);
            PG8_BAR; PG8_WAIT_L(0); PG8_MMA(1, 0, At, B0); PG8_BAR; PG8_SCHED;
            PG8_STAGE(PG8_SB(0, 1), b2 + hstep, voffB);
            PG8_WAIT_V(6); PG8_BAR; PG8_MMA(1, 1, At, B1); PG8_BAR;
            PG8_LDB(B0, 1, 0); PG8_SCHED; PG8_LDA(At, 1, 0); PG8_STAGE(PG8_SA(0, 1), a2 + hstep, voffA);
            PG8_WAIT_L(8); PG8_BAR; PG8_WAIT_L(0); PG8_MMA(0, 0, At, B0); PG8_BAR; PG8_SCHED;
            PG8_LDB(B1, 1, 1); PG8_STAGE(PG8_SB(1, 0), b3, voffB);
            PG8_BAR; PG8_WAIT_L(0); PG8_MMA(0, 1, At, B1); PG8_BAR;
            PG8_LDA(At, 1, 1); PG8_STAGE(PG8_SA(1, 0), a3, voffA);
            PG8_BAR; PG8_WAIT_L(0); PG8_MMA(1, 0, At, B0); PG8_BAR; PG8_SCHED;
            PG8_STAGE(PG8_SB(1, 1), b3 + hstep, voffB);
            PG8_WAIT_V(6); PG8_BAR; PG8_MMA(1, 1, At, B1); PG8_BAR;
            }
        }
        if constexpr (ALIGN_EPI) { if (wr == 0) PG8_BAR; }
        E(acc, cur, wr, wc, fr, fq); S.done(cur);
        if (!has_next) break;
#pragma unroll
        for (int a = 0; a < 2; ++a)
#pragma unroll
            for (int b = 0; b < 2; ++b)
#pragma unroll
                for (int m = 0; m < 4; ++m)
#pragma unroll
                    for (int n = 0; n < 2; ++n) acc[a][b][m][n] = (f32x4){0.f, 0.f, 0.f, 0.f};
        cur = nxt; cA = nA; cB = nB; ++ui;
        if constexpr (ALIGN_EPI) { if (wr == 1) PG8_BAR; }
    }
    PG8_WAIT_V(0);
    if constexpr (!ALIGN_EPI) { if (wr == 0) PG8_BAR; }
    PG8_BAR;
#undef PG8_SA
#undef PG8_SB
#undef PG8_STAGE
#undef PG8_LDA
#undef PG8_LDB
#undef PG8_MMA
#undef PG8_WAIT_V
#undef PG8_WAIT_L
#undef PG8_BAR
#undef PG8_SCHED
}

#define EPI_ROWS_BEGIN \
    _Pragma("unroll") for (int ai = 0; ai < 2; ++ai) _Pragma("unroll") for (int m = 0; m < 4; ++m) { const int row = u.pm * BM + ai * HALF + wr * 64 + m * 16 + fr;
#define EPI_ROWS_END }

struct EpiInProj {
    static constexpr bool PERM = true, HAS_MID = false;
    bf16_t* QKV; bf16_t* GATES; const float* b_gate;
    __device__ __forceinline__ void operator()(const f32x4 (&acc)[2][2][4][2], const Unit& u, int wr, int wc, int fr, int fq) const {
        const int colt = u.pn * BM;
        if (colt < NQKV) {
            const int col0 = colt + wc * 32 + 8 * fq;
            EPI_ROWS_BEGIN
                bf16_t* rowp = QKV + (size_t)row * NQKV + col0;
#pragma unroll
                for (int bj = 0; bj < 2; ++bj) { const f32x4 v0 = acc[ai][bj][m][0], v1 = acc[ai][bj][m][1];
                    u32x4 w; w.x = cvt_pk_bf16(v0[0], v0[1]); w.y = cvt_pk_bf16(v0[2], v0[3]); w.z = cvt_pk_bf16(v1[0], v1[1]); w.w = cvt_pk_bf16(v1[2], v1[3]);
                    *(u32x4*)(rowp + bj * HALF) = w; }
            EPI_ROWS_END
        } else {
            const int col0 = colt - NQKV + wc * 32 + 8 * fq;
            f32x4 bv[2][2];
#pragma unroll
            for (int bj = 0; bj < 2; ++bj)
#pragma unroll
                for (int n = 0; n < 2; ++n) bv[bj][n] = *(const f32x4*)(b_gate + col0 + bj * HALF + 4 * n);
            EPI_ROWS_BEGIN
                bf16_t* rowp = GATES + (size_t)row * NGATE + col0;
#pragma unroll
                for (int bj = 0; bj < 2; ++bj) { f32x4 v0 = acc[ai][bj][m][0] + bv[bj][0], v1 = acc[ai][bj][m][1] + bv[bj][1];
#pragma unroll
                    for (int j = 0; j < 4; ++j) { v0[j] = sigmoid_f(v0[j]); v1[j] = sigmoid_f(v1[j]); }
                    u32x4 w; w.x = cvt_pk_bf16(v0[0], v0[1]); w.y = cvt_pk_bf16(v0[2], v0[3]); w.z = cvt_pk_bf16(v1[0], v1[1]); w.w = cvt_pk_bf16(v1[2], v1[3]);
                    __builtin_nontemporal_store(w, (u32x4*)(rowp + bj * HALF)); }
            EPI_ROWS_END
        }
    }
};
struct EpiMerge {
    static constexpr bool PERM = true, HAS_MID = true;
    bf16_t* T; const bf16_t* GATES; int mid_t;
    __device__ __forceinline__ void mid(f32x4 (&acc)[2][2][4][2], const Unit& u, int wr, int wc, int fr_, int fq_) const {
        const int fr = opq(fr_), fq = opq(fq_);
        const int col0 = u.pn * BM + wc * 32 + 8 * fq;
        EPI_ROWS_BEGIN
#pragma unroll
            for (int bj = 0; bj < 2; ++bj) { const bf16_t* gp = GATES + (size_t)row * NGATE + col0 + bj * HALF;
                const u32x4 a = __builtin_nontemporal_load((const u32x4*)gp), b = *(const u32x4*)(gp + DM);
                const f32x4 r0 = {bf_lo(a.x) * __builtin_amdgcn_rcpf(bf_lo(b.x)), bf_hi(a.x) * __builtin_amdgcn_rcpf(bf_hi(b.x)), bf_lo(a.y) * __builtin_amdgcn_rcpf(bf_lo(b.y)), bf_hi(a.y) * __builtin_amdgcn_rcpf(bf_hi(b.y))};
                const f32x4 r1 = {bf_lo(a.z) * __builtin_amdgcn_rcpf(bf_lo(b.z)), bf_hi(a.z) * __builtin_amdgcn_rcpf(bf_hi(b.z)), bf_lo(a.w) * __builtin_amdgcn_rcpf(bf_lo(b.w)), bf_hi(a.w) * __builtin_amdgcn_rcpf(bf_hi(b.w))};
                acc[ai][bj][m][0] *= r0; acc[ai][bj][m][1] *= r1; }
            asm volatile("" : "+v"(acc[ai][0][m][0]), "+v"(acc[ai][0][m][1]), "+v"(acc[ai][1][m][0]), "+v"(acc[ai][1][m][1]));
            asm volatile("" ::: "memory");
        EPI_ROWS_END
    }
    __device__ __forceinline__ void operator()(const f32x4 (&acc)[2][2][4][2], const Unit& u, int wr, int wc, int fr, int fq) const {
        const int col0 = u.pn * BM + wc * 32 + 8 * fq;
        EPI_ROWS_BEGIN
#pragma unroll
            for (int bj = 0; bj < 2; ++bj) { const u32x4 g = __builtin_nontemporal_load((const u32x4*)(GATES + (size_t)row * NGATE + DM + col0 + bj * HALF));
                const f32x4 g0 = {bf_lo(g.x), bf_hi(g.x), bf_lo(g.y), bf_hi(g.y)}, g1 = {bf_lo(g.z), bf_hi(g.z), bf_lo(g.w), bf_hi(g.w)};
                const f32x4 v0 = acc[ai][bj][m][0] * g0, v1 = acc[ai][bj][m][1] * g1;
                u32x4 w; w.x = cvt_pk_bf16(v0[0], v0[1]); w.y = cvt_pk_bf16(v0[2], v0[3]); w.z = cvt_pk_bf16(v1[0], v1[1]); w.w = cvt_pk_bf16(v1[2], v1[3]);
                *(u32x4*)(T + (size_t)row * DM + col0 + bj * HALF) = w; }
        EPI_ROWS_END
    }
};
struct EpiScaleBf16 {
    static constexpr bool PERM = true, HAS_MID = false;
    bf16_t* D; const float* gvec;
    __device__ __forceinline__ void operator()(const f32x4 (&acc)[2][2][4][2], const Unit& u, int wr, int wc, int fr, int fq) const {
        const int col0 = u.pn * BM + wc * 32 + 8 * fq;
        f32x4 gv[2][2];
#pragma unroll
        for (int bj = 0; bj < 2; ++bj)
#pragma unroll
            for (int n = 0; n < 2; ++n) gv[bj][n] = *(const f32x4*)(gvec + col0 + bj * HALF + 4 * n);
        EPI_ROWS_BEGIN
#pragma unroll
            for (int bj = 0; bj < 2; ++bj) { const f32x4 v0 = gv[bj][0] * acc[ai][bj][m][0], v1 = gv[bj][1] * acc[ai][bj][m][1];
                u32x4 w; w.x = cvt_pk_bf16(v0[0], v0[1]); w.y = cvt_pk_bf16(v0[2], v0[3]); w.z = cvt_pk_bf16(v1[0], v1[1]); w.w = cvt_pk_bf16(v1[2], v1[3]);
                *(u32x4*)(D + (size_t)row * DM + col0 + bj * HALF) = w; }
        EPI_ROWS_END
    }
};
struct EpiResid {
    static constexpr bool PERM = true, HAS_MID = false;
    const float* base; float* out; const float* gvec;
    __device__ __forceinline__ void operator()(const f32x4 (&acc)[2][2][4][2], const Unit& u, int wr, int wc, int fr, int fq) const {
        const int col0 = u.pn * BM + wc * 32 + 8 * fq;
        f32x4 gv[2][2];
#pragma unroll
        for (int bj = 0; bj < 2; ++bj)
#pragma unroll
            for (int n = 0; n < 2; ++n) gv[bj][n] = *(const f32x4*)(gvec + col0 + bj * HALF + 4 * n);
        EPI_ROWS_BEGIN
#pragma unroll
            for (int bj = 0; bj < 2; ++bj) { const size_t off = (size_t)row * DM + col0 + bj * HALF;
                const f32x4 b0 = __builtin_nontemporal_load((const f32x4*)(base + off)), b1 = __builtin_nontemporal_load((const f32x4*)(base + off + 4));
                __builtin_nontemporal_store(b0 + gv[bj][0] * acc[ai][bj][m][0], (f32x4*)(out + off)); __builtin_nontemporal_store(b1 + gv[bj][1] * acc[ai][bj][m][1], (f32x4*)(out + off + 4)); }
            if (m == 3) asm volatile("" ::: "memory");
        EPI_ROWS_END
    }
};
__device__ __forceinline__ f32x4 dpp_ror1(f32x4 v) { f32x4 r;
#pragma unroll
    for (int j = 0; j < 4; ++j) r[j] = __uint_as_float((unsigned)__builtin_amdgcn_update_dpp(0, (int)__float_as_uint(v[j]), 0x121, 0xF, 0xF, false)); return r; }
__device__ __forceinline__ f32x4 dpp_rol1(f32x4 v) { f32x4 r;
#pragma unroll
    for (int j = 0; j < 4; ++j) r[j] = __uint_as_float((unsigned)__builtin_amdgcn_update_dpp(0, (int)__float_as_uint(v[j]), 0x12F, 0xF, 0xF, false)); return r; }
struct EpiUpConv {
    static constexpr bool PERM = true, HAS_MID = false;
    bf16_t* HID; float* EA; float* EP; float* EU; const float* cw; const float* cb; PG8_LAS unsigned char* lds;
    __device__ __forceinline__ void operator()(const f32x4 (&acc)[2][2][4][2], const Unit& u, int wr, int wc, int fr, int fq) const {
        PG8_LAS float* EG = (PG8_LAS float*)(lds + EDGE_OFF);
        const int cl = wc * 32 + 8 * fq;
#pragma unroll
        for (int ai = 0; ai < 2; ++ai) { const int blk = 2 * ai + wr;
            if (fr == 0) {
#pragma unroll
                for (int n = 0; n < 2; ++n) *(PG8_LAS f32x4*)(EG + (blk * 2 + 0) * 128 + cl + 4 * n) = acc[ai][0][0][n]; }
            if (fr == 15) {
#pragma unroll
                for (int n = 0; n < 2; ++n) *(PG8_LAS f32x4*)(EG + (blk * 2 + 1) * 128 + cl + 4 * n) = acc[ai][0][3][n]; } }
        asm volatile("s_waitcnt lgkmcnt(0)" ::: "memory"); __builtin_amdgcn_s_barrier(); asm volatile("" ::: "memory");
        const int col = u.pn * HALF + cl;
        f32x4 w0[2], w1[2], w2[2], bb[2];
#pragma unroll
        for (int n = 0; n < 2; ++n) { w0[n] = *(const f32x4*)(cw + col + 4 * n); w1[n] = *(const f32x4*)(cw + DFF + col + 4 * n); w2[n] = *(const f32x4*)(cw + 2 * DFF + col + 4 * n); bb[n] = *(const f32x4*)(cb + col + 4 * n); }
        const f32x4 zero = {0.f, 0.f, 0.f, 0.f};
#pragma unroll
        for (int ai = 0; ai < 2; ++ai) { const int blk = 2 * ai + wr;
            f32x4 ep[2], en[2];
#pragma unroll
            for (int n = 0; n < 2; ++n) { ep[n] = blk > 0 ? *(const PG8_LAS f32x4*)(EG + ((blk - 1) * 2 + 1) * 128 + cl + 4 * n) : zero;
                                          en[n] = blk < 3 ? *(const PG8_LAS f32x4*)(EG + ((blk + 1) * 2 + 0) * 128 + cl + 4 * n) : zero; }
#pragma unroll
            for (int m = 0; m < 4; ++m) { const int rt = ai * HALF + wr * 64 + m * 16 + fr;
                const size_t row = (size_t)u.pm * BM + rt;
                f32x4 hv[2], cvv[2];
#pragma unroll
                for (int n = 0; n < 2; ++n) { const f32x4 cur = acc[ai][0][m][n];
                    const f32x4 rc = dpp_ror1(cur), lc = dpp_rol1(cur);
                    const f32x4 rp = m > 0 ? dpp_ror1(acc[ai][0][m > 0 ? m - 1 : 0][n]) : ep[n];
                    const f32x4 ln = m < 3 ? dpp_rol1(acc[ai][0][m < 3 ? m + 1 : 3][n]) : en[n];
                    const f32x4 prev = fr == 0 ? rp : rc, next = fr == 15 ? ln : lc;
                    const f32x4 cv = bb[n] + w0[n] * prev + w1[n] * cur + w2[n] * next; cvv[n] = cv;
                    f32x4 sg;
#pragma unroll
                    for (int j = 0; j < 4; ++j) sg[j] = __builtin_amdgcn_rcpf(1.0f + __builtin_amdgcn_exp2f(-cv[j] * LOG2E));
                    hv[n] = cv * sg * acc[ai][1][m][n]; }
                const bool edge = (rt == 0) || (rt == BM - 1);
                if (!edge) { u32x4 w; w.x = cvt_pk_bf16(hv[0][0], hv[0][1]); w.y = cvt_pk_bf16(hv[0][2], hv[0][3]); w.z = cvt_pk_bf16(hv[1][0], hv[1][1]); w.w = cvt_pk_bf16(hv[1][2], hv[1][3]);
                    *(u32x4*)(HID + row * DFF + col) = w; }
                else { const size_t eo = ((size_t)u.pm * 2 + (rt == 0 ? 0 : 1)) * DFF + col;
#pragma unroll
                    for (int n = 0; n < 2; ++n) { *(f32x4*)(EA + eo + 4 * n) = acc[ai][0][m][n]; *(f32x4*)(EP + eo + 4 * n) = cvv[n]; *(f32x4*)(EU + eo + 4 * n) = acc[ai][1][m][n]; } }
            } }
    }
};
}

namespace att {
constexpr int NW = 8, QBLK = 32, KVBLK = 64, LDR = NQKV;
constexpr size_t SHM_V = KVBLK * 128 * 2, SHM_K = KVBLK * 128 * 2;
constexpr size_t SHM_ATTN = 2 * SHM_V + 2 * SHM_K + NW * 64 * 4;
#define KSWZ(row, colB) ((row) * 256 + ((colB) ^ (((row) & 7) << 4)))
#define SBAR() __builtin_amdgcn_sched_barrier(0)
__device__ __forceinline__ int crow(int r, int hi) { return (r & 3) + 8 * (r >> 2) + 4 * hi; }
__device__ __forceinline__ int v_st(int k, int c) { const int kk = (k & ~0xC) | ((k & 4) << 1) | ((k & 8) >> 1); return ((kk >> 3) * 4 + (c >> 5)) * 512 + ((kk & 7) * 32 + (c & 31)) * 2; }
__device__ __forceinline__ int v_rd_base(int lane) { return ((lane & 3) << 3) | (((lane >> 2) & 3) << 6) | (((lane >> 4) & 1) << 5) | (((lane >> 5) & 1) << 8); }
constexpr int v_rd_off(int d0, int ks, int half) { return d0 * 512 + ks * 4096 + half * 2048; }
template <int OFF> __device__ __forceinline__ s16x4 tr_read(int vb) {
    s16x4 r; asm volatile("ds_read_b64_tr_b16 %0, %1 offset:%2" : "=&v"(r) : "v"(vb), "i"(OFF) : "memory"); return r;
}
template <int D0> __device__ __forceinline__ void pv_one(f32x16& od, int vb, bf16x8 pa0, bf16x8 pa1, bf16x8 pa2, bf16x8 pa3) {
    const s16x4 l0 = tr_read<v_rd_off(D0, 0, 0)>(vb), h0 = tr_read<v_rd_off(D0, 0, 1)>(vb), l1 = tr_read<v_rd_off(D0, 1, 0)>(vb), h1 = tr_read<v_rd_off(D0, 1, 1)>(vb);
    const s16x4 l2 = tr_read<v_rd_off(D0, 2, 0)>(vb), h2 = tr_read<v_rd_off(D0, 2, 1)>(vb), l3 = tr_read<v_rd_off(D0, 3, 0)>(vb), h3 = tr_read<v_rd_off(D0, 3, 1)>(vb);
    asm volatile("s_waitcnt lgkmcnt(0)" ::: "memory"); SBAR();
#define PK(L, H) (bf16x8){L[0], L[1], L[2], L[3], H[0], H[1], H[2], H[3]}
    od = __builtin_amdgcn_mfma_f32_32x32x16_bf16(pa0, PK(l0, h0), od, 0, 0, 0);
    od = __builtin_amdgcn_mfma_f32_32x32x16_bf16(pa1, PK(l1, h1), od, 0, 0, 0);
    od = __builtin_amdgcn_mfma_f32_32x32x16_bf16(pa2, PK(l2, h2), od, 0, 0, 0);
    od = __builtin_amdgcn_mfma_f32_32x32x16_bf16(pa3, PK(l3, h3), od, 0, 0, 0);
#undef PK
}
__device__ __forceinline__ void pv_d0(f32x16* o, int vb, bf16x8 pa0, bf16x8 pa1, bf16x8 pa2, bf16x8 pa3) {
    pv_one<0>(o[0], vb, pa0, pa1, pa2, pa3); pv_one<1>(o[1], vb, pa0, pa1, pa2, pa3); pv_one<2>(o[2], vb, pa0, pa1, pa2, pa3); pv_one<3>(o[3], vb, pa0, pa1, pa2, pa3);
}
__device__ __forceinline__ void partialSM(f32x16& p0) {
#pragma unroll
    for (int r = 0; r < 16; ++r) p0[r] = __builtin_amdgcn_exp2f(p0[r]);
}
__device__ __forceinline__ void finishSM(f32x16& p0, f32x16& p1, float& l_reg, bf16x8& pa0, bf16x8& pa1, bf16x8& pa2, bf16x8& pa3) {
#pragma unroll
    for (int r = 0; r < 16; ++r) p1[r] = __builtin_amdgcn_exp2f(p1[r]);
    float ps = 0;
#pragma unroll
    for (int r = 0; r < 16; ++r) ps += p0[r];
#pragma unroll
    for (int r = 0; r < 16; ++r) ps += p1[r];
    { auto rr = __builtin_amdgcn_permlane32_swap(__float_as_uint(ps), __float_as_uint(ps), false, false);
      ps = __uint_as_float(rr[0]) + __uint_as_float(rr[1]); }
    l_reg += ps;
#define PK4(P, BASE, OUT) do { unsigned a0 = cvt_pk_bf16(P[BASE + 0], P[BASE + 1]), a1 = cvt_pk_bf16(P[BASE + 2], P[BASE + 3]);   \
    unsigned b0 = cvt_pk_bf16(P[BASE + 4], P[BASE + 5]), b1 = cvt_pk_bf16(P[BASE + 6], P[BASE + 7]);                              \
    auto r0 = __builtin_amdgcn_permlane32_swap(a0, b0, false, false); auto r1 = __builtin_amdgcn_permlane32_swap(a1, b1, false, false); \
    u32x4 w = {r0[0], r1[0], r0[1], r1[1]}; OUT = *reinterpret_cast<bf16x8*>(&w); } while (0)
    PK4(p0, 0, pa0); PK4(p0, 8, pa1); PK4(p1, 0, pa2); PK4(p1, 8, pa3);
#undef PK4
}
__device__ __forceinline__ void qkt128(f32x16& p0, f32x16& p1, const char* Ks, const bf16x8* qr, int r32, int hi, float negm) {
#pragma unroll
    for (int r = 0; r < 16; ++r) { p0[r] = negm; p1[r] = negm; }
#pragma unroll
    for (int d0 = 0; d0 < 8; ++d0) { const int cb = (d0 * 16 + hi * 8) * 2;
        const bf16x8 b0 = *reinterpret_cast<const bf16x8*>(Ks + KSWZ(r32, cb));
        const bf16x8 b1 = *reinterpret_cast<const bf16x8*>(Ks + KSWZ(32 + r32, cb));
        p0 = __builtin_amdgcn_mfma_f32_32x32x16_bf16(b0, qr[d0], p0, 0, 0, 0);
        p1 = __builtin_amdgcn_mfma_f32_32x32x16_bf16(b1, qr[d0], p1, 0, 0, 0); }
}
__device__ __forceinline__ void qkt64(f32x16& p0, f32x16& p1, const char* Ks, const bf16x8* qr, int r32, int hi, float negm) {
#pragma unroll
    for (int r = 0; r < 16; ++r) { p0[r] = negm; p1[r] = negm; }
    const char* kb = Ks + hi * 1024 + r32 * 16;
#pragma unroll
    for (int d0 = 0; d0 < 4; ++d0) {
        const bf16x8 b0 = *reinterpret_cast<const bf16x8*>(kb + d0 * 2048);
        const bf16x8 b1 = *reinterpret_cast<const bf16x8*>(kb + d0 * 2048 + 512);
        p0 = __builtin_amdgcn_mfma_f32_32x32x16_bf16(b0, qr[d0], p0, 0, 0, 0);
        p1 = __builtin_amdgcn_mfma_f32_32x32x16_bf16(b1, qr[d0], p1, 0, 0, 0); }
}
__device__ __forceinline__ void wmask(f32x16& p0, f32x16& p1, int k0, int qpos, int hi) {
#pragma unroll
    for (int r = 0; r < 16; ++r) { const int kv = k0 + crow(r, hi); int d0 = kv - qpos; d0 = d0 < 0 ? -d0 : d0; int d1 = kv + 32 - qpos; d1 = d1 < 0 ? -d1 : d1;
        if (d0 > 128) p0[r] = -INFINITY; if (d1 > 128) p1[r] = -INFINITY; }
}

#define PIN(x) asm volatile("" : "+v"(x))
__device__ __forceinline__ void qkt64_fin(f32x16& c0, f32x16& c1, const char* Ks, const bf16x8* qr, int r32, int hi, float negm,
                                          const f32x16& p0, const f32x16& p1, float& l_reg, bf16x8& pa0, bf16x8& pa1, bf16x8& pa2, bf16x8& pa3) {
#pragma unroll
    for (int r = 0; r < 16; ++r) { c0[r] = negm; c1[r] = negm; }
    const char* kb = Ks + hi * 1024 + r32 * 16;
    bf16x8 kf[8];
#pragma unroll
    for (int d0 = 0; d0 < 4; ++d0) { kf[2 * d0] = *reinterpret_cast<const bf16x8*>(kb + d0 * 2048); kf[2 * d0 + 1] = *reinterpret_cast<const bf16x8*>(kb + d0 * 2048 + 512); }
    float sacc = 0.f; unsigned a0, a1, b0, b1; u32x4 w;
#define QF_GAP_A(MF, P, B) do { MF; sacc += P[B]; sacc += P[B + 1]; sacc += P[B + 2]; sacc += P[B + 3]; PIN(sacc); a0 = cvt_pk_bf16(P[B], P[B + 1]); a1 = cvt_pk_bf16(P[B + 2], P[B + 3]); PIN(a0); PIN(a1); SBAR(); } while (0)
#define QF_GAP_B(MF, P, B, OUT) do { MF; sacc += P[B]; sacc += P[B + 1]; sacc += P[B + 2]; sacc += P[B + 3]; PIN(sacc); b0 = cvt_pk_bf16(P[B], P[B + 1]); b1 = cvt_pk_bf16(P[B + 2], P[B + 3]); \
        { auto r0 = __builtin_amdgcn_permlane32_swap(a0, b0, false, false); auto r1 = __builtin_amdgcn_permlane32_swap(a1, b1, false, false); w = (u32x4){r0[0], r1[0], r0[1], r1[1]}; } \
        OUT = *reinterpret_cast<bf16x8*>(&w); PIN(OUT); SBAR(); } while (0)
    SBAR();
    QF_GAP_A(c0 = __builtin_amdgcn_mfma_f32_32x32x16_bf16(kf[0], qr[0], c0, 0, 0, 0), p0, 0);
    QF_GAP_B(c1 = __builtin_amdgcn_mfma_f32_32x32x16_bf16(kf[1], qr[0], c1, 0, 0, 0), p0, 4, pa0);
    QF_GAP_A(c0 = __builtin_amdgcn_mfma_f32_32x32x16_bf16(kf[2], qr[1], c0, 0, 0, 0), p0, 8);
    QF_GAP_B(c1 = __builtin_amdgcn_mfma_f32_32x32x16_bf16(kf[3], qr[1], c1, 0, 0, 0), p0, 12, pa1);
    QF_GAP_A(c0 = __builtin_amdgcn_mfma_f32_32x32x16_bf16(kf[4], qr[2], c0, 0, 0, 0), p1, 0);
    QF_GAP_B(c1 = __builtin_amdgcn_mfma_f32_32x32x16_bf16(kf[5], qr[2], c1, 0, 0, 0), p1, 4, pa2);
    QF_GAP_A(c0 = __builtin_amdgcn_mfma_f32_32x32x16_bf16(kf[6], qr[3], c0, 0, 0, 0), p1, 8);
    QF_GAP_B(c1 = __builtin_amdgcn_mfma_f32_32x32x16_bf16(kf[7], qr[3], c1, 0, 0, 0), p1, 12, pa3);
#undef QF_GAP_A
#undef QF_GAP_B
    { auto rr = __builtin_amdgcn_permlane32_swap(__float_as_uint(sacc), __float_as_uint(sacc), false, false); sacc = __uint_as_float(rr[0]) + __uint_as_float(rr[1]); }
    l_reg += sacc;
}
__device__ __forceinline__ void fin_only(const f32x16& p0, const f32x16& p1, float& l_reg, bf16x8& pa0, bf16x8& pa1, bf16x8& pa2, bf16x8& pa3) {
    float ps = 0;
#pragma unroll
    for (int r = 0; r < 16; ++r) ps += p0[r];
#pragma unroll
    for (int r = 0; r < 16; ++r) ps += p1[r];
    { auto rr = __builtin_amdgcn_permlane32_swap(__float_as_uint(ps), __float_as_uint(ps), false, false); ps = __uint_as_float(rr[0]) + __uint_as_float(rr[1]); }
    l_reg += ps;
#define PK4(P, BASE, OUT) do { unsigned a0 = cvt_pk_bf16(P[BASE + 0], P[BASE + 1]), a1 = cvt_pk_bf16(P[BASE + 2], P[BASE + 3]);   \
    unsigned b0 = cvt_pk_bf16(P[BASE + 4], P[BASE + 5]), b1 = cvt_pk_bf16(P[BASE + 6], P[BASE + 7]);                              \
    auto r0 = __builtin_amdgcn_permlane32_swap(a0, b0, false, false); auto r1 = __builtin_amdgcn_permlane32_swap(a1, b1, false, false); \
    u32x4 w = {r0[0], r1[0], r0[1], r1[1]}; OUT = *reinterpret_cast<bf16x8*>(&w); } while (0)
    PK4(p0, 0, pa0); PK4(p0, 8, pa1); PK4(p1, 0, pa2); PK4(p1, 8, pa3);
#undef PK4
}
#define PV_RD(D0, L, H) do { L[0] = tr_read<v_rd_off(D0, 0, 0)>(vb); H[0] = tr_read<v_rd_off(D0, 0, 1)>(vb); L[1] = tr_read<v_rd_off(D0, 1, 0)>(vb); H[1] = tr_read<v_rd_off(D0, 1, 1)>(vb); \
    L[2] = tr_read<v_rd_off(D0, 2, 0)>(vb); H[2] = tr_read<v_rd_off(D0, 2, 1)>(vb); L[3] = tr_read<v_rd_off(D0, 3, 0)>(vb); H[3] = tr_read<v_rd_off(D0, 3, 1)>(vb); } while (0)
#define PV_PK(L, H, k) (bf16x8){L[k][0], L[k][1], L[k][2], L[k][3], H[k][0], H[k][1], H[k][2], H[k][3]}
#define PV_MM(OD, L, H) do { OD = __builtin_amdgcn_mfma_f32_32x32x16_bf16(pa0, PV_PK(L, H, 0), OD, 0, 0, 0); OD = __builtin_amdgcn_mfma_f32_32x32x16_bf16(pa1, PV_PK(L, H, 1), OD, 0, 0, 0); \
    OD = __builtin_amdgcn_mfma_f32_32x32x16_bf16(pa2, PV_PK(L, H, 2), OD, 0, 0, 0); OD = __builtin_amdgcn_mfma_f32_32x32x16_bf16(pa3, PV_PK(L, H, 3), OD, 0, 0, 0); } while (0)
__device__ __forceinline__ void pv_pipe(f32x16* o, int vb, bf16x8 pa0, bf16x8 pa1, bf16x8 pa2, bf16x8 pa3) {
    s16x4 la[4], ha[4], lb[4], hb[4];
    PV_RD(0, la, ha); PV_RD(1, lb, hb);
    asm volatile("s_waitcnt lgkmcnt(8)" ::: "memory"); SBAR(); PV_MM(o[0], la, ha); SBAR();
    PV_RD(2, la, ha);
    asm volatile("s_waitcnt lgkmcnt(8)" ::: "memory"); SBAR(); PV_MM(o[1], lb, hb); SBAR();
    PV_RD(3, lb, hb);
    asm volatile("s_waitcnt lgkmcnt(8)" ::: "memory"); SBAR(); PV_MM(o[2], la, ha); SBAR();
    asm volatile("s_waitcnt lgkmcnt(0)" ::: "memory"); SBAR(); PV_MM(o[3], lb, hb);
}
#define PV_MX(OD, L, H, C, E) do { \
    OD = __builtin_amdgcn_mfma_f32_32x32x16_bf16(pa0, PV_PK(L, H, 0), OD, 0, 0, 0); C[E + 0] = __builtin_amdgcn_exp2f(C[E + 0]); C[E + 1] = __builtin_amdgcn_exp2f(C[E + 1]); PIN(C); SBAR(); \
    OD = __builtin_amdgcn_mfma_f32_32x32x16_bf16(pa1, PV_PK(L, H, 1), OD, 0, 0, 0); C[E + 2] = __builtin_amdgcn_exp2f(C[E + 2]); C[E + 3] = __builtin_amdgcn_exp2f(C[E + 3]); PIN(C); SBAR(); \
    OD = __builtin_amdgcn_mfma_f32_32x32x16_bf16(pa2, PV_PK(L, H, 2), OD, 0, 0, 0); C[E + 4] = __builtin_amdgcn_exp2f(C[E + 4]); C[E + 5] = __builtin_amdgcn_exp2f(C[E + 5]); PIN(C); SBAR(); \
    OD = __builtin_amdgcn_mfma_f32_32x32x16_bf16(pa3, PV_PK(L, H, 3), OD, 0, 0, 0); C[E + 6] = __builtin_amdgcn_exp2f(C[E + 6]); C[E + 7] = __builtin_amdgcn_exp2f(C[E + 7]); PIN(C); SBAR(); } while (0)
__device__ __forceinline__ void pv_pipe_exp(f32x16* o, int vb, bf16x8 pa0, bf16x8 pa1, bf16x8 pa2, bf16x8 pa3, f32x16& c0, f32x16& c1) {
    s16x4 la[4], ha[4], lb[4], hb[4];
    PV_RD(0, la, ha); PV_RD(1, lb, hb);
    asm volatile("s_waitcnt lgkmcnt(8)" ::: "memory"); SBAR(); PV_MX(o[0], la, ha, c0, 0);
    PV_RD(2, la, ha);
    asm volatile("s_waitcnt lgkmcnt(8)" ::: "memory"); SBAR(); PV_MX(o[1], lb, hb, c0, 8);
    PV_RD(3, lb, hb);
    asm volatile("s_waitcnt lgkmcnt(8)" ::: "memory"); SBAR(); PV_MX(o[2], la, ha, c1, 0);
    asm volatile("s_waitcnt lgkmcnt(0)" ::: "memory"); SBAR(); PV_MX(o[3], lb, hb, c1, 8);
}
#undef PV_MX
#undef PV_RD
#undef PV_PK
#undef PV_MM

template <bool WA>
__device__ __forceinline__ void attn_unit(const bf16_t* __restrict__ Qb, const bf16_t* __restrict__ Kh, const bf16_t* __restrict__ Vh,
                                          float* __restrict__ Of, bf16_t* __restrict__ Ob, int ldo,
                                          int NT, int kstart, int nb, int q0, float negm, float l_init, char* lds,
                                          const float* __restrict__ qg, const float* __restrict__ ropetab, float qscale,
                                          bool combine = false, float lam = 0.f, const float* __restrict__ subg = nullptr, bf16_t* __restrict__ Yo = nullptr, int ldy = 0) {
    constexpr int NQ = WA ? 8 : 4;
    constexpr int SLOT_V = 16384, SLOT_K = WA ? 16384 : 8192;
    const int tid = opq(threadIdx.x), wid = __builtin_amdgcn_readfirstlane(tid >> 6), lane = tid & 63, r32 = lane & 31, hi = lane >> 5;
    constexpr int RING = WA ? 3 : 5;
    char* V_lds = lds; char* K_lds = lds + RING * SLOT_V;
    float* ws = (float*)(lds + RING * SLOT_V + RING * SLOT_K) + wid * 64; float* li_l = ws;
    float l_reg = l_init; f32x16 o[4] = {}; bf16x8 qr[NQ];
    const int wrow = WA ? (wid & 1) * QBLK : wid * QBLK, wcol = WA ? (wid >> 1) * 128 : 0;
    const bf16_t* Qw = Qb + (long)(wrow + r32) * LDR + wcol + hi * 8;
#pragma unroll
    for (int d0 = 0; d0 < NQ; ++d0) qr[d0] = *reinterpret_cast<const bf16x8*>(Qw + d0 * 16);
    {
        constexpr int HD = WA ? 128 : 64, QD = HD / 4;
        const int qrow = q0 + wrow + r32;
        float v[NQ][8]; float ss = 0.f;
#pragma unroll
        for (int d0 = 0; d0 < NQ; ++d0) { const u32x4 raw = __builtin_bit_cast(u32x4, qr[d0]);
            v[d0][0] = bf_lo(raw.x); v[d0][1] = bf_hi(raw.x); v[d0][2] = bf_lo(raw.y); v[d0][3] = bf_hi(raw.y); v[d0][4] = bf_lo(raw.z); v[d0][5] = bf_hi(raw.z); v[d0][6] = bf_lo(raw.w); v[d0][7] = bf_hi(raw.w);
#pragma unroll
            for (int j = 0; j < 8; ++j) ss += v[d0][j] * v[d0][j]; }
        ss += shx(ss, 32, lane);
        const float rstd = 1.0f / sqrtf(ss * (1.f / HD) + EPS);
#pragma unroll
        for (int d0 = 0; d0 < NQ; ++d0) { const float* gp = qg + 16 * d0 + 8 * hi; const f32x4 g0 = *(const f32x4*)gp, g1 = *(const f32x4*)(gp + 4);
            const float gg[8] = {g0.x, g0.y, g0.z, g0.w, g1.x, g1.y, g1.z, g1.w};
#pragma unroll
            for (int j = 0; j < 8; ++j) v[d0][j] = v[d0][j] * rstd * gg[j]; }
#pragma unroll
        for (int d0 = 0; d0 < NQ; ++d0) {
            const int axis = WA ? (d0 >> 2) : (d0 >> 1), fi0 = (WA ? 16 * (d0 & 1) : 0) + 8 * hi, dp = WA ? (d0 ^ 2) : (d0 ^ 1); const bool second = WA ? ((d0 & 2) != 0) : ((d0 & 1) != 0);
            const int pos = axis == 0 ? (qrow >> 6) : (qrow & 63);
            const float* cp = ropetab + pos * QD + fi0; const float* sp = ropetab + 256 * QD + pos * QD + fi0;
            const f32x4 c0 = *(const f32x4*)cp, c1 = *(const f32x4*)(cp + 4), s0 = *(const f32x4*)sp, s1 = *(const f32x4*)(sp + 4);
            const float cc[8] = {c0.x, c0.y, c0.z, c0.w, c1.x, c1.y, c1.z, c1.w}, sn[8] = {s0.x, s0.y, s0.z, s0.w, s1.x, s1.y, s1.z, s1.w};
            float w[8];
#pragma unroll
            for (int j = 0; j < 8; ++j) w[j] = (second ? (v[d0][j] * cc[j] + v[dp][j] * sn[j]) : (v[d0][j] * cc[j] - v[dp][j] * sn[j])) * qscale;
            u32x4 o4; o4.x = cvt_pk_bf16(w[0], w[1]); o4.y = cvt_pk_bf16(w[2], w[3]); o4.z = cvt_pk_bf16(w[4], w[5]); o4.w = cvt_pk_bf16(w[6], w[7]);
            qr[d0] = __builtin_bit_cast(bf16x8, o4); }
    }
    const int sr = tid >> 4, sc = (tid & 15) * 8, vst0 = v_st(sr, sc), vst1 = v_st(32 + sr, sc);
    const int vb0 = (int)(uintptr_t)V_lds + v_rd_base(lane);
    const int qpos = q0 + wrow + r32;
    bf16x8 vs0, vs1, ks0, ks1;
#define KOFF(j) ((j) < nb ? kstart + (j) * KVBLK : SEQ + ((j) - nb) * KVBLK)
#define SLOADX(jt, A0, A1, B0, B1) do { const int k0_ = KOFF(jt); \
    A0 = *reinterpret_cast<const bf16x8*>(&Vh[(long)(k0_ + sr) * LDR + sc]); A1 = *reinterpret_cast<const bf16x8*>(&Vh[(long)(k0_ + 32 + sr) * LDR + sc]); \
    if (WA) { B0 = *reinterpret_cast<const bf16x8*>(&Kh[(long)(k0_ + sr) * LDR + sc]); B1 = *reinterpret_cast<const bf16x8*>(&Kh[(long)(k0_ + 32 + sr) * LDR + sc]); } \
    else { B0 = *reinterpret_cast<const bf16x8*>(&Kh[(long)(k0_ + lane) * LDR + wid * 8]); } } while (0)
#define SWRITEX(sv, sk, A0, A1, B0, B1) do { *(bf16x8*)(V_lds + (sv) + vst0) = A0; *(bf16x8*)(V_lds + (sv) + vst1) = A1; \
    if (WA) { const int kc = sc * 2; *(bf16x8*)(K_lds + (sk) + KSWZ(sr, kc)) = B0; *(bf16x8*)(K_lds + (sk) + KSWZ(32 + sr, kc)) = B1; } \
    else { *(bf16x8*)(K_lds + (sk) + wid * 1024 + lane * 16) = B0; } } while (0)
#define SLOAD(jt) SLOADX(jt, vs0, vs1, ks0, ks1)
#define SWRITE(sv, sk) SWRITEX(sv, sk, vs0, vs1, ks0, ks1)
#define QKT(P0, P1, sk) do { if (WA) qkt128(P0, P1, K_lds + (sk), qr, r32, hi, negm); else qkt64(P0, P1, K_lds + (sk), qr, r32, hi, negm); } while (0)
#define MASK(P0, P1, jt) do { if (WA) { if ((jt) < nb) wmask(P0, P1, kstart + (jt) * KVBLK, qpos, hi); } } while (0)
#define PVS(sv) do { if (WA) pv_d0(o, vb0 + (sv), pa0, pa1, pa2, pa3); else pv_pipe(o, vb0 + (sv), pa0, pa1, pa2, pa3); } while (0)
    f32x16 pA0, pA1, pB0, pB1; bf16x8 pa0, pa1, pa2, pa3;
    if (WA) {
    int s_prev = 2, s_cur = 0, s_next = 1;
#define ROT() do { const int t_ = s_prev; s_prev = s_cur; s_cur = s_next; s_next = t_; } while (0)
    { bf16x8 xa0, xa1, xb0, xb1; SLOADX(0, xa0, xa1, xb0, xb1); SLOAD(1); SWRITEX(0, 0, xa0, xa1, xb0, xb1); }
    __syncthreads();
    QKT(pA0, pA1, 0); MASK(pA0, pA1, 0); partialSM(pA0);
    SWRITE(SLOT_V, SLOT_K); if (2 < NT) SLOAD(2);
    __syncthreads(); ROT();
#define STEP(PC0, PC1, PP0, PP1, j) do { \
        if ((j) + 1 < NT) { SWRITE(s_next * SLOT_V, s_next * SLOT_K); } if ((j) + 2 < NT) { SLOAD((j) + 2); } \
        SBAR(); QKT(PC0, PC1, s_cur * SLOT_K); MASK(PC0, PC1, j); \
        finishSM(PP0, PP1, l_reg, pa0, pa1, pa2, pa3); SBAR(); \
        PVS(s_prev * SLOT_V); partialSM(PC0); \
        __syncthreads(); ROT(); } while (0)
    int js = 1;
    for (; js + 1 < NT; js += 2) { STEP(pB0, pB1, pA0, pA1, js); STEP(pA0, pA1, pB0, pB1, js + 1); }
    if (js < NT) { STEP(pB0, pB1, pA0, pA1, js); }
    else { pB0 = pA0; pB1 = pA1; }
    finishSM(pB0, pB1, l_reg, pa0, pa1, pa2, pa3); SBAR(); PVS(s_prev * SLOT_V);
#undef STEP
#undef ROT
    } else {
    int s_pv = 4, s_qk = 0, s_wr = 2;
#define ADV() do { s_pv = s_pv == 4 ? 0 : s_pv + 1; s_qk = s_qk == 4 ? 0 : s_qk + 1; s_wr = s_wr == 4 ? 0 : s_wr + 1; } while (0)
    { bf16x8 xa0, xa1, xb0, xb1, ya0, ya1, yb0, yb1; SLOADX(0, xa0, xa1, xb0, xb1); SLOADX(1, ya0, ya1, yb0, yb1); SLOAD(2);
      SWRITEX(0, 0, xa0, xa1, xb0, xb1); SWRITEX(SLOT_V, SLOT_K, ya0, ya1, yb0, yb1); }
    __syncthreads();
    SWRITE(2 * SLOT_V, 2 * SLOT_K); if (3 < NT) SLOAD(3);
    QKT(pA0, pA1, 0); partialSM(pA0); partialSM(pA1);
    ADV();
#define ITER(PC0, PC1, PP0, PP1, j, BARRIER) do { \
        if ((wid >> 2) == ((BARRIER) ? 0 : 1)) __builtin_amdgcn_s_setprio(1); else __builtin_amdgcn_s_setprio(0);     \
        if ((j) + 2 < NT) { SWRITE(s_wr * SLOT_V, s_wr * SLOT_K); } if ((j) + 3 < NT) { SLOAD((j) + 3); } \
        qkt64_fin(PC0, PC1, K_lds + s_qk * SLOT_K, qr, r32, hi, negm, PP0, PP1, l_reg, pa0, pa1, pa2, pa3); \
        pv_pipe_exp(o, vb0 + s_pv * SLOT_V, pa0, pa1, pa2, pa3, PC0, PC1); \
        if (BARRIER) __syncthreads(); \
        ADV(); } while (0)
    for (int j = 1; j + 1 < NT; j += 2) { ITER(pB0, pB1, pA0, pA1, j, true); ITER(pA0, pA1, pB0, pB1, j + 1, false); }
    ITER(pB0, pB1, pA0, pA1, NT - 1, false);
    __builtin_amdgcn_s_setprio(0);
    fin_only(pB0, pB1, l_reg, pa0, pa1, pa2, pa3); SBAR(); pv_pipe(o, vb0 + s_pv * SLOT_V, pa0, pa1, pa2, pa3);
#undef ITER
#undef ADV
    }
    if (hi == 0) li_l[r32] = l_reg; asm volatile("s_waitcnt lgkmcnt(0)" ::: "memory");
    float rli[16];
#pragma unroll
    for (int r = 0; r < 16; ++r) rli[r] = __builtin_amdgcn_rcpf(li_l[crow(r, hi)]);
    if (WA) {
        bf16_t* Ow = Ob + (long)wrow * ldo + wcol;
#pragma unroll
        for (int r = 0; r < 16; ++r) { const int orow = crow(r, hi);
#pragma unroll
            for (int d0 = 0; d0 < 4; ++d0) { const unsigned w = cvt_pk_bf16(o[d0][r] * rli[r], 0.f); Ow[(long)orow * ldo + d0 * 32 + r32] = (bf16_t)(w & 0xffffu); } }
    } else if (!combine) {
        float* Ow = Of + (long)(wid * QBLK) * ldo;
#pragma unroll
        for (int r = 0; r < 16; ++r) { const int orow = crow(r, hi);
#pragma unroll
            for (int d0 = 0; d0 < 4; ++d0) Ow[(long)orow * ldo + d0 * 32 + r32] = o[d0][r] * rli[r]; }
    } else {
        const float* Ow = Of + (long)(wid * QBLK) * ldo;
        float gsub[4];
#pragma unroll
        for (int d0 = 0; d0 < 4; ++d0) gsub[d0] = subg[d0 * 32 + r32] * 0.8f;
        bf16_t* Yw = Yo + (long)(wid * QBLK) * ldy;
#pragma unroll
        for (int r = 0; r < 16; ++r) { const int orow = crow(r, hi);
            float d[4]; float ss = 0.f;
#pragma unroll
            for (int d0 = 0; d0 < 4; ++d0) { d[d0] = Ow[(long)orow * ldo + d0 * 32 + r32] - lam * (o[d0][r] * rli[r]); ss += d[d0] * d[d0]; }
            ss += shx(ss, 1, lane); ss += shx(ss, 2, lane); ss += shx(ss, 4, lane); ss += shx(ss, 8, lane); ss += shx(ss, 16, lane);
            const float rs = 1.0f / sqrtf(ss * (1.f / 128.f) + EPS);
#pragma unroll
            for (int d0 = 0; d0 < 4; ++d0) { const unsigned w = cvt_pk_bf16(d[d0] * rs * gsub[d0], 0.f); Yw[(long)orow * ldy + d0 * 32 + r32] = (bf16_t)(w & 0xffffu); } }
    }
    __syncthreads();
#undef KOFF
#undef SLOAD
#undef SLOADX
#undef SWRITEX
#undef SWRITE
#undef QKT
#undef MASK
#undef PVS
#undef ROT
#undef STEP
}
#undef SBAR
}

#define XB_TMO      128
#define XB_XCNT(j)  (256  + 64 * (j))
#define XB_XSUB(j)  (1280 + 64 * (j))
#define XB_XGEN(j)  (2304 + 64 * (j))
#define XB_TOP      3328
#define XB_TOPGEN   3392
#define XCD_BAR_WORDS 3456
#define XB_SPIN_CAP (1u << 18)
static_assert((size_t)(CW_BAR + XCD_BAR_WORDS) * 4 <= CTL_ZERO_BYTES, "the per-call memset must cover every barrier word");
__device__ __forceinline__ unsigned xb_ld(unsigned* p)              { return __hip_atomic_load(p, __ATOMIC_RELAXED, __HIP_MEMORY_SCOPE_AGENT); }
__device__ __forceinline__ unsigned xb_add(unsigned* p, unsigned v) { return __hip_atomic_fetch_add(p, v, __ATOMIC_RELAXED, __HIP_MEMORY_SCOPE_AGENT); }
__device__ __forceinline__ unsigned xb_xcc_id() { return (unsigned)__builtin_amdgcn_s_getreg((3 << 11) | 20) & 0xFu; }
#define XB_SPIN(cond, bar) do { unsigned _sp = 0; while (cond) { __builtin_amdgcn_s_sleep(1); \
    if ((++_sp & 255u) == 0u) { if (xb_ld(&(bar)[XB_TMO])) break; if (_sp > XB_SPIN_CAP) { atomicAdd(&(bar)[XB_TMO], 1u); break; } } } } while (0)
struct XcdBarrier { unsigned* bar; unsigned x; volatile LAS unsigned* st; };
__device__ __forceinline__ XcdBarrier xcd_barrier_post(unsigned* bar, volatile LAS unsigned* st) {
    XcdBarrier b; b.bar = bar; b.x = xb_xcc_id(); b.st = st;
    if (threadIdx.x == 0) (void)xb_add(&bar[XB_XCNT(b.x)], 1u);
    return b;
}
__device__ __forceinline__ void xcd_barrier_complete(unsigned* bar, unsigned x, unsigned& nloc, unsigned& nx) {
    const unsigned G = gridDim.x * gridDim.y * gridDim.z;
    unsigned sum, cnt, mine, sp = 0u;
    for (;;) {
        sum = 0u; cnt = 0u; mine = 0u;
#pragma unroll
        for (unsigned j = 0; j < 16; ++j) { const unsigned c = xb_ld(&bar[XB_XCNT(j)]); sum += c; cnt += (c > 0u) ? 1u : 0u; mine = (j == x) ? c : mine; }
        if (sum == G) break;
        __builtin_amdgcn_s_sleep(1);
        if ((++sp & 255u) == 0u) { if (xb_ld(&bar[XB_TMO])) break; if (sp > XB_SPIN_CAP) { atomicAdd(&bar[XB_TMO], 1u); break; } }
    }
    nloc = mine > 0u ? mine : 1u; nx = cnt > 0u ? cnt : 1u;
}
__device__ __forceinline__ void xcd_barrier(const XcdBarrier& b) {
    asm volatile("s_waitcnt vmcnt(0)" ::: "memory");
    __syncthreads();
    if (threadIdx.x == 0) {
        unsigned* bar = b.bar;
        __builtin_amdgcn_s_waitcnt(0);
        unsigned nloc = b.st[0], nx = b.st[1];
        if (nloc == 0u) { xcd_barrier_complete(bar, b.x, nloc, nx); b.st[0] = nloc; b.st[1] = nx; }
        const unsigned old = xb_add(&bar[XB_XSUB(b.x)], 1u);
        const unsigned gen = old / nloc;
        if (old + 1u == (gen + 1u) * nloc) {
            __builtin_amdgcn_fence(__ATOMIC_RELEASE, "agent");
            asm volatile("s_waitcnt vmcnt(0)" ::: "memory");
            const unsigned og = xb_add(&bar[XB_TOP], 1u);
            const unsigned tg = og / nx;
            if (og + 1u == (tg + 1u) * nx) xb_add(&bar[XB_TOPGEN], 1u);
            else XB_SPIN(xb_ld(&bar[XB_TOPGEN]) == tg, bar);
            __builtin_amdgcn_fence(__ATOMIC_ACQUIRE, "agent");
            xb_add(&bar[XB_XGEN(b.x)], 1u);
            asm volatile("s_waitcnt vmcnt(0)" ::: "memory");
        } else {
            XB_SPIN(xb_ld(&bar[XB_XGEN(b.x)]) == gen, bar);
            __builtin_amdgcn_fence(__ATOMIC_ACQUIRE, "agent");
            asm volatile("s_waitcnt vmcnt(0)" ::: "memory");
        }
    }
    __syncthreads();
}

struct Args {
    const float* in[27];
    float* out;
    unsigned char* ws;
};
enum { I_X = 0, I_C, I_CTX, I_CCTX, I_WADA, I_BADA, I_ANG, I_WIN, I_BGATE, I_DAQG, I_DAKG, I_LQ1, I_LK1, I_LQ2, I_LK2, I_SUBG, I_WAQG, I_WAKG, I_SINK,
       I_WODA, I_WOWA, I_WOUT, I_FNG, I_WUP, I_CONVW, I_CONVB, I_WDN };
enum { V_A1 = 0, V_B1, V_A1C, V_B1C, V_G1, V_A2, V_B2, V_G2 };

template <bool NTST = false>
__device__ __forceinline__ void transpose_item(const float* W, int K, int N, bf16_t* WT, int k0, int n0, int orow0, LAS float* scr, int lane, int ldw = 0, int kofs = 0) {
    if (ldw == 0) ldw = K;
#pragma unroll 8
    for (int i = 0; i < 32; ++i) { const int kk = 2 * i + (lane >> 5); scr[kk * 33 + (lane & 31)] = __builtin_nontemporal_load(&W[(size_t)(k0 + kk) * N + n0 + (lane & 31)]); }
    LDS_WAIT(); asm volatile("" ::: "memory");
    const int c = lane & 7;
#pragma unroll
    for (int j = 0; j < 4; ++j) { const int n = (lane >> 3) + 8 * j; const LAS float* s = scr + (8 * c) * 33 + n;
        u32x4 o; o.x = cvt_pk_bf16(s[0 * 33], s[1 * 33]); o.y = cvt_pk_bf16(s[2 * 33], s[3 * 33]); o.z = cvt_pk_bf16(s[4 * 33], s[5 * 33]); o.w = cvt_pk_bf16(s[6 * 33], s[7 * 33]);
        if (NTST) __builtin_nontemporal_store(o, (GAS u32x4*)(WT + (size_t)(orow0 + n) * ldw + kofs + k0 + 8 * c)); else *(GAS u32x4*)(WT + (size_t)(orow0 + n) * ldw + kofs + k0 + 8 * c) = o; }
    LDS_WAIT(); asm volatile("" ::: "memory");
}

__device__ __forceinline__ void rms_mod_row(const float* xrow, const float* Av, const float* Bv, bf16_t* orow, int lane, const bf16_t* add = nullptr, float* sumrow = nullptr) {
    const GAS f32x4* xr = (const GAS f32x4*)xrow + lane;
    f32x4 v[16]; float s = 0.f;
    if (add) {
        const GAS u32x2* ar = (const GAS u32x2*)add + lane; GAS f32x4* sr = (GAS f32x4*)sumrow + lane;
#pragma unroll
        for (int j = 0; j < 16; ++j) { const u32x2 a = __builtin_nontemporal_load(&ar[64 * j]); v[j] = __builtin_nontemporal_load(&xr[64 * j]); v[j].x += bf_lo(a.x); v[j].y += bf_hi(a.x); v[j].z += bf_lo(a.y); v[j].w += bf_hi(a.y); __builtin_nontemporal_store(v[j], &sr[64 * j]);
            s += (v[j].x * v[j].x + v[j].y * v[j].y) + (v[j].z * v[j].z + v[j].w * v[j].w); }
    } else
#pragma unroll
    for (int j = 0; j < 16; ++j) { v[j] = __builtin_nontemporal_load(&xr[64 * j]); s += (v[j].x * v[j].x + v[j].y * v[j].y) + (v[j].z * v[j].z + v[j].w * v[j].w); }
    const float rstd = 1.0f / sqrtf(wave_sum(s, lane) * (1.f / DM) + EPS);
    GAS u32x2* o8 = (GAS u32x2*)orow + lane;
    const GAS f32x4* a4 = (const GAS f32x4*)Av + lane; const GAS f32x4* b4 = (const GAS f32x4*)Bv + lane;
#pragma unroll
    for (int j = 0; j < 16; ++j) { const f32x4 a = a4[64 * j], b = b4[64 * j]; const f32x4 y = v[j] * rstd * a + b;
        u32x2 w; w.x = cvt_pk_bf16(y.x, y.y); w.y = cvt_pk_bf16(y.z, y.w); o8[64 * j] = w; }
}

__device__ __forceinline__ float max_abs64(const float* g, int n, int lane) {
    float m = fabsf(g[lane]); if (n > 64) m = fmaxf(m, fabsf(g[64 + lane]));
#pragma unroll
    for (int o = 1; o < 64; o <<= 1) m = fmaxf(m, shx(m, o, lane));
    return m;
}

__global__ void __launch_bounds__(NWAVES * 64, 2) fwd_kernel(Args args) {
    extern __shared__ __attribute__((aligned(16))) unsigned char lds[];
    LAS unsigned char* ldsl = (LAS unsigned char*)lds;
    volatile LAS unsigned* MISC = (volatile LAS unsigned*)(ldsl + MISC_OFF);
    const int wave = __builtin_amdgcn_readfirstlane((int)threadIdx.x >> 6);
    const int G = gridDim.x, bx = blockIdx.x;
#define PHASE_IDS const int tid = opq(threadIdx.x), lane = tid & 63; (void)tid; (void)lane
    const int vcu = (G % 8 == 0) ? (bx % 8) * (G / 8) + bx / 8 : bx;
    const int gw = vcu * NWAVES + wave, NGW = G * NWAVES;
    unsigned char* ws = args.ws;
    unsigned* ctl = (unsigned*)(ws + WS_CTL);
    for (int u = threadIdx.x; u < (LDS_BYTES - LDSCTL_OFF) / 4; u += NWAVES * 64) ((LAS unsigned*)(ldsl + LDSCTL_OFF))[u] = 0u;
    __syncthreads();
    XcdBarrier bar = xcd_barrier_post(ctl + CW_BAR, MISC + 8);

    const float* x = args.in[I_X];
    float* out = args.out;
    float* part = (float*)(ws + WS_PART); float* partc = (float*)(ws + WS_PARTC);
    float* vec = (float*)(ws + WS_VEC);
    float* rope_da = (float*)(ws + WS_ROPE_DA); float* rope_wa = (float*)(ws + WS_ROPE_WA);
    bf16_t* WupT = (bf16_t*)(ws + WS_WUP); bf16_t* WdnT = (bf16_t*)(ws + WS_WDN); bf16_t* WoutT = (bf16_t*)(ws + WS_WOUT);
    bf16_t* WodaT = (bf16_t*)(ws + WS_WODA); bf16_t* WowaT = (bf16_t*)(ws + WS_WOWA); bf16_t* WinT = (bf16_t*)(ws + WS_WIN);
    bf16_t* Hb = (bf16_t*)(ws + WS_H); bf16_t* QKV = (bf16_t*)(ws + WS_QKV); bf16_t* GATES = (bf16_t*)(ws + WS_GATES);
    float* O01 = (float*)(ws + WS_O01); float* T1 = (float*)(ws + WS_O01);
    bf16_t* Yda = (bf16_t*)(ws + WS_YDA); bf16_t* Ywa = (bf16_t*)(ws + WS_YWA);
    bf16_t* Tb = (bf16_t*)(ws + WS_T); bf16_t* H2 = (bf16_t*)(ws + WS_H2); bf16_t* D6 = (bf16_t*)(ws + WS_H);
    bf16_t* HID = (bf16_t*)(ws + WS_HID); float* EDG = (float*)(ws + WS_EDGE);

    {
        PHASE_IDS;
        LAS float* sc_ = (LAS float*)ldsl; LAS float* scc_ = sc_ + DM;
        for (int i = tid; i < DM; i += NWAVES * 64) { sc_[i] = silu_f(args.in[I_C][i]); scc_[i] = silu_f(args.in[I_CCTX][i]); }
        __syncthreads();
        const float* wada = args.in[I_WADA];
        for (int item = gw; item < 96 * 16; item += NGW) {
            const int cg = item % 96, kc = item / 96, n0 = 256 * cg + 4 * lane; const bool isctx = cg < 32;
            f32x4 a0 = {0.f, 0.f, 0.f, 0.f}, a1 = {0.f, 0.f, 0.f, 0.f};
            const float* wp = wada + (size_t)(256 * kc) * NADA + n0;
            for (int k = 0; k < 256; k += 8) {
                f32x4 w[8];
#pragma unroll
                for (int j = 0; j < 8; ++j) w[j] = __builtin_nontemporal_load((const GAS f32x4*)(wp + (size_t)(k + j) * NADA));
#pragma unroll
                for (int j = 0; j < 8; ++j) { const float s = sc_[256 * kc + k + j]; a0 += w[j] * s; if (isctx) { const float s2 = scc_[256 * kc + k + j]; a1 += w[j] * s2; } }
            }
            *(f32x4*)(part + (size_t)kc * NADA + n0) = a0;
            if (isctx) *(f32x4*)(partc + (size_t)kc * 8192 + n0) = a1;
        }
        for (int i = bx * (NWAVES * 64) + tid; i < 256 * 48; i += G * NWAVES * 64) {
            const int pos = i / 48, f = i % 48; const bool da = f < 16; const int fi = da ? f : f - 16;
            const float freq = __builtin_amdgcn_exp2f(-(float)fi * (da ? (1.f / 16.f) : (1.f / 32.f)) * 13.287712379549449f);
            const float ang = (float)pos * freq; float rev = ang * 0.15915494309189535f; rev = rev - floorf(rev);
            const float cs = __builtin_amdgcn_cosf(rev), sn = __builtin_amdgcn_sinf(rev);
            if (da) { rope_da[pos * 16 + fi] = cs; rope_da[256 * 16 + pos * 16 + fi] = sn; }
            else { rope_wa[pos * 32 + fi] = cs; rope_wa[256 * 32 + pos * 32 + fi] = sn; }
        }
        __syncthreads();
        LAS float* scr = (LAS float*)(ldsl + wave * 16384);
        constexpr int I_IN = 64 * 544, I_ODA = 32 * 128, I_OWA = 32 * 128, I_OUT = 64 * 128, I_UP = 64 * 688, I_DN = 172 * 128;
        constexpr int NITEMS = I_IN + I_UP;
        for (int it = gw; it < NITEMS; it += NGW) {
            int r = it;
            if (r < I_IN) { const int kb = r / 544, nb = r % 544; transpose_item(args.in[I_WIN], DM, NIN, WinT, 64 * kb, 32 * nb, 32 * nb, scr, lane); continue; } r -= I_IN;
            if (r < I_UP) { const int kb = r / 688, nb = r % 688; const int n0 = 32 * nb; const bool isu = n0 >= DFF; const int j0 = isu ? n0 - DFF : n0;
                const int orow0 = (j0 >> 7) * 256 + (isu ? 128 : 0) + (j0 & 127);
                transpose_item<true>(args.in[I_WUP], DM, NUP, WupT, 64 * kb, n0, orow0, scr, lane); }
        }
    }
    xcd_barrier(bar);

    {
        PHASE_IDS;
        const float* bada = args.in[I_BADA];
        for (int d = bx * (NWAVES * 64) + tid; d < DM; d += G * NWAVES * 64) {
            float m[6], mc[2];
#pragma unroll
            for (int q = 0; q < 6; ++q) { float s = bada[q * DM + d]; for (int kc = 0; kc < 16; ++kc) s += part[(size_t)kc * NADA + q * DM + d]; m[q] = s; }
#pragma unroll
            for (int q = 0; q < 2; ++q) { float s = bada[q * DM + d]; for (int kc = 0; kc < 16; ++kc) s += partc[(size_t)kc * 8192 + q * DM + d]; mc[q] = s; }
            const float ag = args.in[I_ANG][d], fg = args.in[I_FNG][d];
            vec[V_A1 * DM + d] = ag * (1.f + m[1]); vec[V_B1 * DM + d] = m[0];
            vec[V_A1C * DM + d] = ag * (1.f + mc[1]); vec[V_B1C * DM + d] = mc[0];
            vec[V_G1 * DM + d] = m[2];
            vec[V_A2 * DM + d] = fg * (1.f + m[4]); vec[V_B2 * DM + d] = m[3];
            vec[V_G2 * DM + d] = m[5];
        }
    }
    xcd_barrier(bar);

    { PHASE_IDS;
    for (int m = gw; m < MR; m += NGW) {
        const bool isl = m < SEQ;
        const float* src = isl ? x + (size_t)m * DM : args.in[I_CTX] + (size_t)(m - SEQ) * DM;
        rms_mod_row(src, vec + (isl ? V_A1 : V_A1C) * DM, vec + (isl ? V_B1 : V_B1C) * DM, Hb + (size_t)m * DM, lane);
    } }
    xcd_barrier(bar);

    {
        pg8::Gemm g{Hb, WinT, SEQ, NIN, DM}; pg8::StaticOrder S; S.init(SEQ, NIN, G, bx);
        pg8::EpiInProj E{QKV, GATES, args.in[I_BGATE]};
        pg8::gemm_phase<pg8::EpiInProj, pg8::StaticOrder, false, true>(ldsl, g, S, E);
    }
    xcd_barrier(bar);

    {
#define QK_BODY(raw, p_, row, col, kind) do { \
            const bool isl_ = (row) < SEQ; \
            float v[8] = {bf_lo(raw.x), bf_hi(raw.x), bf_lo(raw.y), bf_hi(raw.y), bf_lo(raw.z), bf_hi(raw.z), bf_lo(raw.w), bf_hi(raw.w)}; \
            float ss = 0.f; \
            _Pragma("unroll") for (int j = 0; j < 8; ++j) ss += v[j] * v[j]; \
            const bool wa = (kind) >= 2; \
            ss += shx(ss, 1, lane); ss += shx(ss, 2, lane); ss += shx(ss, 4, lane); \
            const float ss16 = ss + shx(ss, 8, lane); \
            const int hd = wa ? 128 : 64; \
            const float rstd = 1.0f / sqrtf((wa ? ss16 : ss) * (1.f / hd) + EPS); \
            const int d0 = (col) & (hd - 1);                      \
            const float* gsrc = args.in[(kind) == 0 ? I_DAQG : (kind) == 1 ? I_DAKG : (kind) == 2 ? I_WAQG : I_WAKG] + d0; \
            const f32x4 g0 = *(const f32x4*)gsrc, g1 = *(const f32x4*)(gsrc + 4); \
            const float gg[8] = {g0.x, g0.y, g0.z, g0.w, g1.x, g1.y, g1.z, g1.w}; \
            _Pragma("unroll") for (int j = 0; j < 8; ++j) v[j] = v[j] * rstd * gg[j]; \
            if (isl_) {   \
                const int qd = hd / 4; \
                const int axis = d0 / (hd / 2), idx = d0 % (hd / 2); const bool second = idx >= qd; const int fi = idx % qd; \
                const int pos = axis == 0 ? ((row) >> 6) : ((row) & 63); \
                const float* tab = wa ? rope_wa : rope_da; \
                const float* cp = tab + pos * qd + fi; const float* sp = tab + 256 * qd + pos * qd + fi; \
                const f32x4 c0 = *(const f32x4*)cp, c1 = *(const f32x4*)(cp + 4), s0 = *(const f32x4*)sp, s1 = *(const f32x4*)(sp + 4); \
                const float cc[8] = {c0.x, c0.y, c0.z, c0.w, c1.x, c1.y, c1.z, c1.w}, sn[8] = {s0.x, s0.y, s0.z, s0.w, s1.x, s1.y, s1.z, s1.w}; \
                const int pl = wa ? 4 : 2;                                 \
                _Pragma("unroll") for (int j = 0; j < 8; ++j) { const float other = shx(v[j], pl, lane); \
                    v[j] = second ? (v[j] * cc[j] + other * sn[j]) : (v[j] * cc[j] - other * sn[j]); } \
            } \
            const float qs = (kind) == 0 ? DA_C : (kind) == 2 ? WA_C : 1.0f; \
            u32x4 w; w.x = cvt_pk_bf16(v[0] * qs, v[1] * qs); w.y = cvt_pk_bf16(v[2] * qs, v[3] * qs); w.z = cvt_pk_bf16(v[4] * qs, v[5] * qs); w.w = cvt_pk_bf16(v[6] * qs, v[7] * qs); \
            *(GAS u32x4*)p_ = w; } while (0)
#define QK_PIECE(row, col, kind) do { bf16_t* pp_ = QKV + (size_t)(row) * NQKV + (col); const u32x4 rr_ = *(const GAS u32x4*)pp_; QK_BODY(rr_, pp_, row, col, kind); } while (0)
        constexpr int NCTXT = 20;
        if (bx < NCTXT) {
            const int pn = bx < 16 ? 8 + bx : 32 + (bx - 16);
            { pg8::Gemm g{Hb, WinT, MR, NIN, DM}; pg8::SingleOrder S{SEQ / 256, pn};
              pg8::EpiInProj E{QKV, GATES, args.in[I_BGATE]};
              pg8::gemm_phase<pg8::EpiInProj, pg8::SingleOrder, true, true>(ldsl, g, S, E); }
            const bool isk = (pn < 16) || (pn == 32) || (pn == 33);
            if (isk) {
                VM_WAIT(); __syncthreads();
                PHASE_IDS;
                const int kind = pn < 16 ? 1 : 3, col = pn * 256 + 8 * (lane & 31);
                const bool wa = kind == 3; const int hd = wa ? 128 : 64;
                const float* gsrc = args.in[wa ? I_WAKG : I_DAKG] + (col & (hd - 1));
                const f32x4 g0 = *(const f32x4*)gsrc, g1 = *(const f32x4*)(gsrc + 4);
                const float gg[8] = {g0.x, g0.y, g0.z, g0.w, g1.x, g1.y, g1.z, g1.w};
                u32x4 raw[16];
#pragma unroll
                for (int i = 0; i < 16; ++i) raw[i] = *(const GAS u32x4*)(QKV + (size_t)(SEQ + 32 * wave + 2 * i + (lane >> 5)) * NQKV + col);
                float ssv[16];
#pragma unroll
                for (int i = 0; i < 16; ++i) { const float v[8] = {bf_lo(raw[i].x), bf_hi(raw[i].x), bf_lo(raw[i].y), bf_hi(raw[i].y), bf_lo(raw[i].z), bf_hi(raw[i].z), bf_lo(raw[i].w), bf_hi(raw[i].w)};
                    float ss = 0.f;
#pragma unroll
                    for (int j = 0; j < 8; ++j) ss += v[j] * v[j];
                    ssv[i] = ss; }
#pragma unroll
                for (int m = 1; m < 8; m <<= 1)
#pragma unroll
                    for (int i = 0; i < 16; ++i) ssv[i] += shx(ssv[i], m, lane);
                if (wa) {
#pragma unroll
                    for (int i = 0; i < 16; ++i) ssv[i] += shx(ssv[i], 8, lane); }
#pragma unroll
                for (int i = 0; i < 16; ++i) { const float rstd = 1.0f / sqrtf(ssv[i] * (1.f / hd) + EPS);
                    float v[8] = {bf_lo(raw[i].x), bf_hi(raw[i].x), bf_lo(raw[i].y), bf_hi(raw[i].y), bf_lo(raw[i].z), bf_hi(raw[i].z), bf_lo(raw[i].w), bf_hi(raw[i].w)};
#pragma unroll
                    for (int j = 0; j < 8; ++j) v[j] = v[j] * rstd * gg[j];
                    u32x4 w; w.x = cvt_pk_bf16(v[0], v[1]); w.y = cvt_pk_bf16(v[2], v[3]); w.z = cvt_pk_bf16(v[4], v[5]); w.w = cvt_pk_bf16(v[6], v[7]);
                    *(GAS u32x4*)(QKV + (size_t)(SEQ + 32 * wave + 2 * i + (lane >> 5)) * NQKV + col) = w; }
            }
        } else if (G > NCTXT) {
            PHASE_IDS;
            const int gw2 = (bx - NCTXT) * NWAVES + wave, NGW2 = (G - NCTXT) * NWAVES;
            for (int it = gw2; it < SEQ * 5; it += 4 * NGW2) {
                u32x4 rb[4]; bf16_t* pb[4]; int rw[4], cl[4], kd[4];
#pragma unroll
                for (int u = 0; u < 4; ++u) { const int itu = it + u * NGW2; const int itc = itu < SEQ * 5 ? itu : it; const int row = itc / 5, c = itc % 5;
                    rw[u] = row; if (c < 4) { cl[u] = 2048 + 512 * c + 8 * lane; kd[u] = 1; } else { cl[u] = OFF_KW + 8 * lane; kd[u] = 3; }
                    pb[u] = QKV + (size_t)row * NQKV + cl[u]; rb[u] = *(const GAS u32x4*)pb[u]; }
#pragma unroll
                for (int u = 0; u < 4; ++u) { if (u == 0 || it + u * NGW2 < SEQ * 5) QK_BODY(rb[u], pb[u], rw[u], cl[u], kd[u]); }
            }
            LAS float* scr = (LAS float*)(ldsl + wave * 16384);
            constexpr int I_ODA = 32 * 128, I_OWA = 32 * 128, I_OUT = 64 * 128;
            for (int it = gw2; it < I_ODA + I_OWA + I_OUT; it += NGW2) {
                int r = it;
                if (r < I_ODA) { const int kb = r / 128, nb = r % 128; transpose_item<true>(args.in[I_WODA], 2048, DM, WodaT, 64 * kb, 32 * nb, 32 * nb, scr, lane, DM, 0); continue; } r -= I_ODA;
                if (r < I_OWA) { const int kb = r / 128, nb = r % 128; transpose_item<true>(args.in[I_WOWA], 2048, DM, WodaT, 64 * kb, 32 * nb, 32 * nb, scr, lane, DM, 2048); continue; } r -= I_OWA;
                { const int kb = r / 128, nb = r % 128; transpose_item<true>(args.in[I_WOUT], DM, DM, WoutT, 64 * kb, 32 * nb, 32 * nb, scr, lane); }
            }
        }
#undef QK_PIECE
#undef QK_BODY
    }
    xcd_barrier(bar);

    {
        PHASE_IDS;
        const float mda = __uint_as_float(__builtin_amdgcn_readfirstlane(__float_as_uint(8.0f * max_abs64(args.in[I_DAQG], 64, lane) * max_abs64(args.in[I_DAKG], 64, lane))));
        float lam;
        { const float a = args.in[I_LQ1][lane] * args.in[I_LK1][lane], b = args.in[I_LQ2][lane] * args.in[I_LK2][lane];
          lam = __uint_as_float(__builtin_amdgcn_readfirstlane(__float_as_uint(__expf(wave_sum(a, lane)) - __expf(wave_sum(b, lane)) + 0.2f))); }
        for (int t = bx; t < 2048; t += G) {
            const int xq = t & 7, j = (t >> 3) & 31, i = t >> 8;
            const int h = 2 * xq + (i >> 2), mp = (i >> 1) & 1, qb = (i & 1) * 32 + j;
            const bf16_t* Qb = QKV + (size_t)(qb * 256) * NQKV + (2 * h + mp) * 64;
            const bf16_t* Kh = QKV + OFF_KA + (2 * h + mp) * 64;
            const bf16_t* Vh = QKV + OFF_VA + h * 128;
            float* Of = O01 + (size_t)(qb * 256) * 2048 + h * 128;
            att::attn_unit<false>(Qb, Kh, Vh, Of, nullptr, 2048, MR / 64, 0, MR / 64, qb * 256, -mda * LOG2E, 0.f, (char*)lds, args.in[I_DAQG], rope_da, DA_C,
                                  mp == 1, lam, args.in[I_SUBG], Yda + (size_t)(qb * 256) * DM + h * 128, DM);
        }
        const int lane2 = opq(threadIdx.x) & 63;
        const float mwa = __uint_as_float(__builtin_amdgcn_readfirstlane(__float_as_uint(11.313708498984761f * max_abs64(args.in[I_WAQG], 128, lane2) * max_abs64(args.in[I_WAKG], 128, lane2))));
        for (int t = bx; t < 1024; t += G) {
            const int xq = t & 7, kvh = xq >> 1, rb = (xq & 1) * 128 + (t >> 3);
            const int q0 = rb * 64, hq = 4 * kvh + (wave >> 1);
            const int ks = q0 - 128 < 0 ? 0 : q0 - 128; const int ke = q0 + 192 > SEQ ? SEQ : q0 + 192; const int nb = (ke - ks) / 64;
            const float sink = args.in[I_SINK][hq];
            const float mh = fmaxf(mwa, sink);
            const bf16_t* Qb = QKV + (size_t)q0 * NQKV + OFF_QW + kvh * 512;
            const bf16_t* Kh = QKV + OFF_KW + kvh * 128;
            const bf16_t* Vh = QKV + OFF_VW + kvh * 128;
            bf16_t* Ob = Yda + (size_t)q0 * DM + 2048 + kvh * 512;
            att::attn_unit<true>(Qb, Kh, Vh, nullptr, Ob, DM, nb + CTX / 64, ks, nb, q0, -mh * LOG2E, __builtin_amdgcn_exp2f((sink - mh) * LOG2E), (char*)lds, args.in[I_WAQG], rope_wa, WA_C);
        }
    }
    xcd_barrier(bar);

    {
        pg8::Gemm g{Yda, WodaT, SEQ, DM, DM}; pg8::StaticOrder S; S.init(SEQ, DM, G, bx);
        pg8::EpiMerge E{Tb, GATES, 32};
        pg8::gemm_phase<pg8::EpiMerge, pg8::StaticOrder, false, true>(ldsl, g, S, E);
    }
    xcd_barrier(bar);
    {
        pg8::Gemm g{Tb, WoutT, SEQ, DM, DM}; pg8::StaticOrder S; S.init(SEQ, DM, G, bx);
        pg8::EpiScaleBf16 E{D6, vec + V_G1 * DM};
        pg8::gemm_phase<pg8::EpiScaleBf16, pg8::StaticOrder, false, true>(ldsl, g, S, E);
    }
    xcd_barrier(bar);
    { PHASE_IDS; for (int m = gw; m < SEQ; m += NGW) rms_mod_row(x + (size_t)m * DM, vec + V_A2 * DM, vec + V_B2 * DM, H2 + (size_t)m * DM, lane, D6 + (size_t)m * DM, out + (size_t)m * DM); }
    xcd_barrier(bar);
    {
        pg8::Gemm g{H2, WupT, SEQ, NUP, DM}; pg8::StaticOrder S; S.init(SEQ, NUP, G, bx);
        pg8::EpiUpConv E{HID, EDG, EDG + EDGE_ELEMS, EDG + 2 * EDGE_ELEMS, args.in[I_CONVW], args.in[I_CONVB], ldsl};
        pg8::gemm_phase<pg8::EpiUpConv, pg8::StaticOrder, true, true>(ldsl, g, S, E);
        const int nshort = G - (64 * 86) % G;
        if ((64 * 86) % G != 0 ? bx >= G - nshort : true) {
            PHASE_IDS;
            LAS float* scr = (LAS float*)(ldsl + wave * 16384);
            const int first = (64 * 86) % G != 0 ? G - nshort : 0, nconv = (64 * 86) % G != 0 ? nshort : G;
            for (int r = (bx - first) * NWAVES + wave; r < 172 * 128; r += nconv * NWAVES) { const int kb = r / 128, nb = r % 128; transpose_item(args.in[I_WDN], DFF, DM, WdnT, 64 * kb, 32 * nb, 32 * nb, scr, lane); }
        }
    }
    xcd_barrier(bar);
    {
        PHASE_IDS;
        const float* cw = args.in[I_CONVW];
        const float* EA = EDG; const float* EP = EDG + EDGE_ELEMS; const float* EU = EDG + 2 * EDGE_ELEMS;
        constexpr int NCH = DFF / 4;
        for (int it = bx * (NWAVES * 64) + tid; it < 128 * NCH; it += G * NWAVES * 64) {
            const int er = it / NCH, c = 4 * (it % NCH); const int pm = er >> 1, e = er & 1;
            const size_t row = (size_t)pm * 256 + (e ? 255 : 0);
            const f32x4 part = *(const GAS f32x4*)(EP + (size_t)er * DFF + c), uu = *(const GAS f32x4*)(EU + (size_t)er * DFF + c);
            f32x4 an = {0.f, 0.f, 0.f, 0.f};
            if (e == 0 && pm > 0) an = *(const GAS f32x4*)(EA + ((size_t)(pm - 1) * 2 + 1) * DFF + c);
            if (e == 1 && pm < 63) an = *(const GAS f32x4*)(EA + ((size_t)(pm + 1) * 2 + 0) * DFF + c);
            const f32x4 wm = *(const GAS f32x4*)(cw + (e ? 2 * DFF : 0) + c);
            const f32x4 cv = part + wm * an; f32x4 hv;
#pragma unroll
            for (int j = 0; j < 4; ++j) hv[j] = cv[j] * __builtin_amdgcn_rcpf(1.0f + __builtin_amdgcn_exp2f(-cv[j] * LOG2E)) * uu[j];
            u32x2 w; w.x = cvt_pk_bf16(hv[0], hv[1]); w.y = cvt_pk_bf16(hv[2], hv[3]);
            *(GAS u32x2*)(HID + row * DFF + c) = w;
        }
    }
    xcd_barrier(bar);
    {
        pg8::Gemm g{HID, WdnT, SEQ, DM, DFF}; pg8::StaticOrder S; S.init(SEQ, DM, G, bx, 2);
        pg8::EpiResid E{out, out, vec + V_G2 * DM};
        pg8::gemm_phase<pg8::EpiResid, pg8::StaticOrder, false, true>(ldsl, g, S, E);
    }
    if (xb_ld(ctl + CW_BAR + XB_TMO) != 0u) {
        VM_WAIT(); __syncthreads();
        const float qn = __builtin_nanf("");
        for (size_t i = (size_t)bx * (NWAVES * 64) + threadIdx.x; i < (size_t)SEQ * DM / 4; i += (size_t)G * NWAVES * 64) ((f32x4*)out)[i] = (f32x4){qn, qn, qn, qn};
    }
}

extern "C" void kernel_launch(void* const* d_in, const int* in_sizes, int n_in, void* d_out, int out_size, void* d_ws, size_t ws_size, hipStream_t stream) {
    static int grid = 0;
    if (grid == 0) {
        if (n_in != 27 || out_size != SEQ * DM || ws_size < WS_END) { fprintf(stderr, "kernel_launch: unexpected shapes (n_in %d out %d ws %zu need %zu)\n", n_in, out_size, ws_size, (size_t)WS_END); grid = -1; return; }
        int dev = 0, cus = 0, per_cu = 0;
        if (hipGetDevice(&dev) != hipSuccess || hipDeviceGetAttribute(&cus, hipDeviceAttributeMultiprocessorCount, dev) != hipSuccess) { grid = -1; return; }
        if (hipFuncSetAttribute((const void*)fwd_kernel, hipFuncAttributeMaxDynamicSharedMemorySize, LDS_BYTES) != hipSuccess) { fprintf(stderr, "kernel_launch: hipFuncSetAttribute failed\n"); grid = -1; return; }
        if (hipOccupancyMaxActiveBlocksPerMultiprocessor(&per_cu, (const void*)fwd_kernel, NWAVES * 64, LDS_BYTES) != hipSuccess || per_cu < 1)
            fprintf(stderr, "kernel_launch: occupancy query reports %d workgroups per CU\n", per_cu);
        (void)hipGetLastError();
        grid = cus;
        if (512 % grid != 0) { fprintf(stderr, "kernel_launch: %d CUs: this build pairs the two maps of a differential-attention head through a 512 %% grid == 0 unit deal; nothing launched\n", grid); grid = -1; return; }
    }
    if (grid < 0) return;
    if (hipMemsetAsync((char*)d_ws + WS_CTL, 0, CTL_ZERO_BYTES, stream) != hipSuccess) { fprintf(stderr, "kernel_launch: memset failed\n"); return; }
    Args a{};
    for (int i = 0; i < 27; ++i) a.in[i] = (const float*)d_in[i];
    a.out = (float*)d_out; a.ws = (unsigned char*)d_ws;
    hipLaunchKernelGGL(fwd_kernel, dim3(grid), dim3(NWAVES * 64), LDS_BYTES, stream, a);
    const hipError_t le = hipPeekAtLastError();
    if (le != hipSuccess) fprintf(stderr, "kernel_launch: launch failed: %s\n", hipGetErrorName(le));
}
```

```cpp
#include <hip/hip_runtime.h>
#include <cstdio>
#include <cstdint>

#define GAS __attribute__((address_space(1)))
#define LAS __attribute__((address_space(3)))

typedef unsigned short bf16_t;
typedef short bf16x8 __attribute__((ext_vector_type(8)));
typedef short s16x4 __attribute__((ext_vector_type(4)));
typedef float f32x4 __attribute__((ext_vector_type(4)));
typedef float f32x2 __attribute__((ext_vector_type(2)));
typedef float f32x16 __attribute__((ext_vector_type(16)));
typedef unsigned u32x4 __attribute__((ext_vector_type(4)));
typedef unsigned u32x2 __attribute__((ext_vector_type(2)));

constexpr int DM = 4096, SEQ = 16384, CTX = 256, MR = SEQ + CTX;
constexpr int NIN = 17408, NQKV = 9216, NGATE = 8192, DFF = 11008, NUP = 22016, NADA = 24576;
constexpr int OFF_KA = 2048, OFF_VA = 4096, OFF_QW = 6144, OFF_KW = 8192, OFF_VW = 8704;
constexpr float EPS = 1e-6f;
constexpr float LOG2E = 1.4426950408889634f;
constexpr float DA_C = 0.125f * LOG2E;
constexpr float WA_C = 0.08838834764831845f * LOG2E;
constexpr int NWAVES = 8;

constexpr size_t MiB = 1u << 20;
constexpr size_t WS_CTL = 0, CTL_ZERO_BYTES = 32768;
constexpr size_t WS_PART = 1 * MiB;
constexpr size_t WS_PARTC = WS_PART + (size_t)16 * NADA * 4;
constexpr size_t WS_VEC = 3 * MiB;
constexpr size_t WS_ROPE_DA = WS_VEC + 8 * 4096 * 4;
constexpr size_t WS_ROPE_WA = WS_ROPE_DA + 2 * 256 * 16 * 4;
constexpr size_t WS_WUP = 4 * MiB;
constexpr size_t WS_WDN = 176 * MiB;
constexpr size_t WS_WOUT = 262 * MiB;
constexpr size_t WS_WODA = 294 * MiB;
constexpr size_t WS_WOWA = 310 * MiB;
constexpr size_t WS_WIN = 326 * MiB;
constexpr size_t WS_H = 462 * MiB;
constexpr size_t WS_QKV = 592 * MiB;
constexpr size_t WS_GATES = 885 * MiB;
constexpr size_t WS_O01 = 1145 * MiB;
constexpr size_t WS_YDA = 1401 * MiB;
constexpr size_t WS_YWA = 1465 * MiB;
constexpr size_t WS_END = 1529 * MiB;
constexpr size_t WS_T = WS_QKV;
constexpr size_t WS_H2 = WS_WOUT;
constexpr size_t WS_A = 390 * MiB;
constexpr size_t WS_U = 734 * MiB;
constexpr size_t WS_HID = 1078 * MiB;
constexpr size_t WS_EDGE = 400 * MiB;
constexpr size_t EDGE_ELEMS = (size_t)64 * 2 * DFF;
static_assert(WS_WIN + (size_t)NIN * DM * 2 <= WS_H && WS_H + (size_t)MR * DM * 2 <= WS_QKV && WS_QKV + (size_t)MR * NQKV * 2 <= WS_GATES, "ws map 1");
static_assert(WS_GATES + (size_t)MR * NGATE * 2 <= WS_O01 && WS_O01 + (size_t)2 * SEQ * 2048 * 4 <= WS_YDA && WS_HID + (size_t)SEQ * DFF * 2 <= WS_END, "ws map 2");
static_assert(WS_H2 + (size_t)SEQ * DM * 2 <= WS_A && WS_A + (size_t)SEQ * DFF * 2 <= WS_U && WS_U + (size_t)SEQ * DFF * 2 <= WS_HID, "ws map 3");
static_assert(WS_ROPE_WA + 2 * 256 * 32 * 4 <= WS_WUP, "ws map 0");
constexpr int CW_BAR = 4096;

constexpr int RING_BYTES = 131072;
constexpr int LDSCTL_OFF = RING_BYTES, MISC_OFF = LDSCTL_OFF + 320;
constexpr int LDS_BYTES = 147456;
constexpr int EDGE_OFF = LDSCTL_OFF + 1024;

#define LDS_WAIT() asm volatile("s_waitcnt lgkmcnt(0)" ::: "memory")
#define VM_WAIT() asm volatile("s_waitcnt vmcnt(0)" ::: "memory")

typedef __bf16 bf16x2_t __attribute__((ext_vector_type(2)));
__device__ __forceinline__ unsigned cvt_pk_bf16(float lo, float hi) { const f32x2 v = {lo, hi}; const bf16x2_t b = __builtin_convertvector(v, bf16x2_t); return __builtin_bit_cast(unsigned, b); }
__device__ __forceinline__ float bf_lo(unsigned w) { return __uint_as_float(w << 16); }
__device__ __forceinline__ float bf_hi(unsigned w) { return __uint_as_float(w & 0xffff0000u); }
__device__ __forceinline__ float shx(float v, int m, int lane) { return __uint_as_float((unsigned)__builtin_amdgcn_ds_bpermute((lane ^ m) << 2, (int)__float_as_uint(v))); }
__device__ __forceinline__ float wave_sum(float v, int lane) {
#pragma unroll
    for (int o = 1; o < 64; o <<= 1) v += shx(v, o, lane);
    return v;
}
__device__ __forceinline__ int opq(int v) { asm volatile("" : "+v"(v)); return v; }
__device__ __forceinline__ float silu_f(float x) { return x / (1.0f + __expf(-x)); }
__device__ __forceinline__ float sigmoid_f(float x) { return __builtin_amdgcn_rcpf(1.0f + __builtin_amdgcn_exp2f(-x * LOG2E)); }

namespace pg8 {
#define PG8_LAS __attribute__((address_space(3)))
constexpr int BM = 256, BK = 64, HALF = 128, HTB = HALF * BK * 2, STAGE_BYTES = 8 * HTB, NXCD = 8, WGM = 8;
__host__ __device__ __forceinline__ int lds_byte(int r, int c) { const int st = (r >> 4) * 2 + (c >> 5), rr = r & 15, cc = c & 31, ob = rr * 64 + cc * 2; return st * 1024 + (ob ^ (((ob >> 9) & 1) << 5)); }
__host__ __device__ __forceinline__ void stage_rc(int b, int& R, int& C) { const int st = b / 1024, sb = b % 1024, swz = sb ^ (((sb >> 9) & 1) << 5); R = (st >> 1) * 16 + swz / 64; C = (st & 1) * 32 + (swz % 64) / 2; }
__host__ __device__ __forceinline__ int perm32(int rho) { const int n = rho >> 4, i = rho & 15; return 8 * (i >> 2) + 4 * n + (i & 3); }
struct Unit { int pm, pn; };
struct Gemm { const bf16_t* A; const bf16_t* Bt; int M, N, K; };
struct StaticOrder {
    int nM, nN, nwg, G, c, wgm;
    __host__ __device__ void init(int M, int N, int G_, int c_, int wgm_ = WGM) { nM = M / BM; nN = N / BM; nwg = nM * nN; G = G_; c = c_; wgm = wgm_; }
    __host__ __device__ bool next(int i, Unit& u) const {
        const long L = (long)i * G + c; if (L >= nwg) return false;
        int wgid = (int)L; { const int q = nwg / NXCD, r = nwg % NXCD, xcd = wgid % NXCD, off = wgid / NXCD; wgid = (xcd < r ? xcd * (q + 1) : r * (q + 1) + (xcd - r) * q) + off; }
        const int nig = wgm * nN, gid = wgid / nig, fm = gid * wgm, gsz = (nM - fm) < wgm ? (nM - fm) : wgm;
        u.pm = fm + ((wgid % nig) % gsz); u.pn = (wgid % nig) / gsz; return true;
    }
    __device__ __forceinline__ void a_ready(const Unit&) const {}
    __device__ __forceinline__ void done(const Unit&) const {}
};

struct SingleOrder {
    int pm, pn;
    __device__ __forceinline__ bool next(int i, Unit& u) const { if (i != 0) return false; u.pm = pm; u.pn = pn; return true; }
    __device__ __forceinline__ void a_ready(const Unit&) const {}
    __device__ __forceinline__ void done(const Unit&) const {}
};
template <class Epi, class Sched, bool ALIGN_EPI = false, bool SP2 = false>
__device__ __forceinline__ void gemm_phase(PG8_LAS unsigned char* lds, const Gemm g, const Sched& S, const Epi& E) {
    const int tid = opq(threadIdx.x), wid = __builtin_amdgcn_readfirstlane(tid >> 6), lane = tid & 63, wr = wid >> 2, wc = wid & 3, fr = lane & 15, fq = lane >> 4;
    const int K = g.K, nt = K / BK;
    unsigned voffA[2], voffB[2];
#pragma unroll
    for (int i = 0; i < 2; ++i) { int R, C; stage_rc(tid * 16 + i * 8192, R, C); const int Rb = Epi::PERM ? ((R & ~31) + perm32(R & 31)) : R;
        voffA[i] = (unsigned)(R * K + C) * 2u; voffB[i] = (unsigned)(Rb * K + C) * 2u; }
    const size_t kstep = (size_t)(BK * 2);
    const size_t hstep = (size_t)HALF * K * 2;
    const size_t tstep = 2 * hstep;
    const unsigned ldsw = (unsigned)wid * 1024u;
    const int aoff = lds_byte(wr * 64 + fr, fq * 8), boff = lds_byte(wc * 32 + fr, fq * 8);
#define PG8_SA(b, h) (((b) * 2 + (h)) * HTB)
#define PG8_SB(b, h) ((4 + (b) * 2 + (h)) * HTB)
#define PG8_STAGE(bufoff, gbase, voff) do { _Pragma("unroll") for (int _i = 0; _i < 2; ++_i) \
        __builtin_amdgcn_global_load_lds((const unsigned*)((const char*)(gbase) + (voff)[_i]), (PG8_LAS unsigned*)(lds + (bufoff) + ldsw + _i * 8192), 16, 0, 0); } while (0)
#define PG8_LDA(dst, b, h) do { _Pragma("unroll") for (int m = 0; m < 4; ++m) _Pragma("unroll") for (int k = 0; k < 2; ++k) dst[m][k] = *(const PG8_LAS bf16x8*)(lds + PG8_SA(b, h) + aoff + m * 2048 + k * 1024); } while (0)
#define PG8_LDB(dst, b, h) do { _Pragma("unroll") for (int n = 0; n < 2; ++n) _Pragma("unroll") for (int k = 0; k < 2; ++k) dst[n][k] = *(const PG8_LAS bf16x8*)(lds + PG8_SB(b, h) + boff + n * 2048 + k * 1024); } while (0)
#define PG8_MMA(ai, bj, At, Bt) do { __builtin_amdgcn_s_setprio(1); _Pragma("unroll") for (int m = 0; m < 4; ++m) _Pragma("unroll") for (int n = 0; n < 2; ++n) _Pragma("unroll") for (int k = 0; k < 2; ++k) \
        acc[ai][bj][m][n] = __builtin_amdgcn_mfma_f32_16x16x32_bf16(Bt[n][k], At[m][k], acc[ai][bj][m][n], 0, 0, 0); __builtin_amdgcn_s_setprio(0); } while (0)
#define PG8_WAIT_V(n) asm volatile("s_waitcnt vmcnt(" #n ")" ::: "memory")
#define PG8_WAIT_L(n) asm volatile("s_waitcnt lgkmcnt(" #n ")" ::: "memory")
#define PG8_BAR __builtin_amdgcn_s_barrier()
#define PG8_SCHED __builtin_amdgcn_sched_barrier(0)
    Unit cur, nxt; int ui = 0;
    if (!S.next(0, cur)) return;
    f32x4 acc[2][2][4][2];
#pragma unroll
    for (int a = 0; a < 2; ++a)
#pragma unroll
        for (int b = 0; b < 2; ++b)
#pragma unroll
            for (int m = 0; m < 4; ++m)
#pragma unroll
                for (int n = 0; n < 2; ++n) acc[a][b][m][n] = (f32x4){0.f, 0.f, 0.f, 0.f};
    bf16x8 At[4][2], B0[2][2], B1[2][2];
    const char* cA = (const char*)g.A + (size_t)cur.pm * tstep; const char* cB = (const char*)g.Bt + (size_t)cur.pn * tstep;
    S.a_ready(cur);
    if constexpr (SP2) {
        PG8_STAGE(PG8_SB(0, 0), cB, voffB); PG8_STAGE(PG8_SB(0, 1), cB + hstep, voffB); PG8_STAGE(PG8_SA(0, 0), cA, voffA); PG8_STAGE(PG8_SA(0, 1), cA + hstep, voffA);
        if (wr == 1) PG8_BAR;
        PG8_WAIT_V(2); PG8_BAR;
        PG8_STAGE(PG8_SB(1, 0), cB + kstep, voffB); PG8_STAGE(PG8_SA(1, 0), cA + kstep, voffA); PG8_STAGE(PG8_SB(1, 1), cB + hstep + kstep, voffB);
        PG8_WAIT_V(6); PG8_BAR;
    } else {
        PG8_STAGE(PG8_SB(0, 0), cB, voffB); PG8_STAGE(PG8_SA(0, 0), cA, voffA); PG8_STAGE(PG8_SB(0, 1), cB + hstep, voffB); PG8_STAGE(PG8_SA(0, 1), cA + hstep, voffA);
        if (wr == 1) PG8_BAR;
        PG8_WAIT_V(4); PG8_BAR;
        PG8_STAGE(PG8_SB(1, 0), cB + kstep, voffB); PG8_STAGE(PG8_SA(1, 0), cA + kstep, voffA); PG8_STAGE(PG8_SB(1, 1), cB + hstep + kstep, voffB);
        PG8_WAIT_V(6); PG8_BAR;
    }
    for (;;) {
        const bool has_next = S.next(ui + 1, nxt);
        const char* nA = has_next ? (const char*)g.A + (size_t)nxt.pm * tstep : cA; const char* nB = has_next ? (const char*)g.Bt + (size_t)nxt.pn * tstep : cB;
        for (int t = 0; t < nt; t += 2) {
            const bool last = (t == nt - 2);
            const char* a1 = cA + (size_t)(t + 1) * kstep;
            const char* a2 = last ? nA : cA + (size_t)(t + 2) * kstep; const char* b2 = last ? nB : cB + (size_t)(t + 2) * kstep;
            const char* a3 = a2 + kstep; const char* b3 = b2 + kstep;
            if (last && has_next) S.a_ready(nxt);
            if constexpr (Epi::HAS_MID) { if (t == E.mid_t) E.mid(acc, cur, wr, wc, fr, fq); }
            if constexpr (SP2) {
            PG8_LDB(B0, 0, 0); PG8_LDB(B1, 0, 1); PG8_SCHED; PG8_LDA(At, 0, 0); PG8_STAGE(PG8_SA(1, 1), a1 + hstep, voffA);
            PG8_WAIT_V(8); PG8_WAIT_L(0); PG8_BAR; PG8_MMA(0, 0, At, B0); PG8_MMA(0, 1, At, B1); PG8_BAR; PG8_SCHED;
            PG8_LDA(At, 0, 1); PG8_STAGE(PG8_SB(0, 0), b2, voffB); PG8_STAGE(PG8_SB(0, 1), b2 + hstep, voffB); PG8_STAGE(PG8_SA(0, 0), a2, voffA);
            PG8_WAIT_V(8); PG8_WAIT_L(0); PG8_BAR; PG8_MMA(1, 0, At, B0); PG8_MMA(1, 1, At, B1); PG8_BAR; PG8_SCHED;
            PG8_LDB(B0, 1, 0); PG8_LDB(B1, 1, 1); PG8_SCHED; PG8_LDA(At, 1, 0); PG8_STAGE(PG8_SA(0, 1), a2 + hstep, voffA);
            PG8_WAIT_V(8); PG8_WAIT_L(0); PG8_BAR; PG8_MMA(0, 0, At, B0); PG8_MMA(0, 1, At, B1); PG8_BAR; PG8_SCHED;
            PG8_LDA(At, 1, 1); PG8_STAGE(PG8_SB(1, 0), b3, voffB); PG8_STAGE(PG8_SB(1, 1), b3 + hstep, voffB); PG8_STAGE(PG8_SA(1, 0), a3, voffA);
            PG8_WAIT_V(8); PG8_WAIT_L(0); PG8_BAR; PG8_MMA(1, 0, At, B0); PG8_MMA(1, 1, At, B1); PG8_BAR; PG8_SCHED;
            } else {
            PG8_LDB(B0, 0, 0); PG8_SCHED; PG8_LDA(At, 0, 0); PG8_STAGE(PG8_SA(1, 1), a1 + hstep, voffA);
            PG8_WAIT_L(8); PG8_BAR; PG8_WAIT_L(0); PG8_MMA(0, 0, At, B0); PG8_BAR; PG8_SCHED;
            PG8_LDB(B1, 0, 1); PG8_STAGE(PG8_SB(0, 0), b2, voffB);
            PG8_BAR; PG8_WAIT_L(0); PG8_MMA(0, 1, At, B1); PG8_BAR;
            PG8_LDA(At, 0, 1); PG8_STAGE(PG8_SA(0, 0), a2, voffA);
            PG8_BAR; PG8_WAIT_L(0); PG8_MMA(1, 0, At, B0); PG8_BAR; PG8_SCHED;
            PG8_STAGE(PG8_SB(0, 1), b2 + hstep, voffB);
            PG8_WAIT_V(6); PG8_BAR; PG8_MMA(1, 1, At, B1); PG8_BAR;
            PG8_LDB(B0, 1, 0); PG8_SCHED; PG8_LDA(At, 1, 0); PG8_STAGE(PG8_SA(0, 1), a2 + hstep, voffA);
            PG8_WAIT_L(8); PG8_BAR; PG8_WAIT_L(0); PG8_MMA(0, 0, At, B0); PG8_BAR; PG8_SCHED;
            PG8_LDB(B1, 1, 1); PG8_STAGE(PG8_SB(1, 0), b3, voffB);
            PG8_BAR; PG8_WAIT_L(0); PG8_MMA(0, 1, At, B1); PG8_BAR;
            PG8_LDA(At, 1, 1); PG8_STAGE(PG8_SA(1, 0), a3, voffA);
            PG8_BAR; PG8_WAIT_L(0); PG8_MMA(1, 0, At, B0); PG8_BAR; PG8_SCHED;
            PG8_STAGE(PG8_SB(1, 1), b3 + hstep, voffB);
            PG8_WAIT_V(6); PG8_BAR; PG8_MMA(1, 1, At, B1); PG8_BAR;
            }
        }
        if constexpr (ALIGN_EPI) { if (wr == 0) PG8_BAR; }
        E(acc, cur, wr, wc, fr, fq); S.done(cur);
        if (!has_next) break;
#pragma unroll
        for (int a = 0; a < 2; ++a)
#pragma unroll
            for (int b = 0; b < 2; ++b)
#pragma unroll
                for (int m = 0; m < 4; ++m)
#pragma unroll
                    for (int n = 0; n < 2; ++n) acc[a][b][m][n] = (f32x4){0.f, 0.f, 0.f, 0.f};
        cur = nxt; cA = nA; cB = nB; ++ui;
        if constexpr (ALIGN_EPI) { if (wr == 1) PG8_BAR; }
    }
    PG8_WAIT_V(0);
    if constexpr (!ALIGN_EPI) { if (wr == 0) PG8_BAR; }
    PG8_BAR;
#undef PG8_SA
#undef PG8_SB
#undef PG8_STAGE
#undef PG8_LDA
#undef PG8_LDB
#undef PG8_MMA
#undef PG8_WAIT_V
#undef PG8_WAIT_L
#undef PG8_BAR
#undef PG8_SCHED
}

#define EPI_ROWS_BEGIN \
    _Pragma("unroll") for (int ai = 0; ai < 2; ++ai) _Pragma("unroll") for (int m = 0; m < 4; ++m) { const int row = u.pm * BM + ai * HALF + wr * 64 + m * 16 + fr;
#define EPI_ROWS_END }

struct EpiInProj {
    static constexpr bool PERM = true, HAS_MID = false;
    bf16_t* QKV; bf16_t* GATES; const float* b_gate;
    __device__ __forceinline__ void operator()(const f32x4 (&acc)[2][2][4][2], const Unit& u, int wr, int wc, int fr, int fq) const {
        const int colt = u.pn * BM;
        if (colt < NQKV) {
            const int col0 = colt + wc * 32 + 8 * fq;
            EPI_ROWS_BEGIN
                bf16_t* rowp = QKV + (size_t)row * NQKV + col0;
#pragma unroll
                for (int bj = 0; bj < 2; ++bj) { const f32x4 v0 = acc[ai][bj][m][0], v1 = acc[ai][bj][m][1];
                    u32x4 w; w.x = cvt_pk_bf16(v0[0], v0[1]); w.y = cvt_pk_bf16(v0[2], v0[3]); w.z = cvt_pk_bf16(v1[0], v1[1]); w.w = cvt_pk_bf16(v1[2], v1[3]);
                    *(u32x4*)(rowp + bj * HALF) = w; }
            EPI_ROWS_END
        } else {
            const int col0 = colt - NQKV + wc * 32 + 8 * fq;
            f32x4 bv[2][2];
#pragma unroll
            for (int bj = 0; bj < 2; ++bj)
#pragma unroll
                for (int n = 0; n < 2; ++n) bv[bj][n] = *(const f32x4*)(b_gate + col0 + bj * HALF + 4 * n);
            EPI_ROWS_BEGIN
                bf16_t* rowp = GATES + (size_t)row * NGATE + col0;
#pragma unroll
                for (int bj = 0; bj < 2; ++bj) { f32x4 v0 = acc[ai][bj][m][0] + bv[bj][0], v1 = acc[ai][bj][m][1] + bv[bj][1];
#pragma unroll
                    for (int j = 0; j < 4; ++j) { v0[j] = sigmoid_f(v0[j]); v1[j] = sigmoid_f(v1[j]); }
                    u32x4 w; w.x = cvt_pk_bf16(v0[0], v0[1]); w.y = cvt_pk_bf16(v0[2], v0[3]); w.z = cvt_pk_bf16(v1[0], v1[1]); w.w = cvt_pk_bf16(v1[2], v1[3]);
                    __builtin_nontemporal_store(w, (u32x4*)(rowp + bj * HALF)); }
            EPI_ROWS_END
        }
    }
};
struct EpiMerge {
    static constexpr bool PERM = true, HAS_MID = true;
    bf16_t* T; const bf16_t* GATES; int mid_t;
    __device__ __forceinline__ void mid(f32x4 (&acc)[2][2][4][2], const Unit& u, int wr, int wc, int fr_, int fq_) const {
        const int fr = opq(fr_), fq = opq(fq_);
        const int col0 = u.pn * BM + wc * 32 + 8 * fq;
        EPI_ROWS_BEGIN
#pragma unroll
            for (int bj = 0; bj < 2; ++bj) { const bf16_t* gp = GATES + (size_t)row * NGATE + col0 + bj * HALF;
                const u32x4 a = __builtin_nontemporal_load((const u32x4*)gp), b = *(const u32x4*)(gp + DM);
                const f32x4 r0 = {bf_lo(a.x) * __builtin_amdgcn_rcpf(bf_lo(b.x)), bf_hi(a.x) * __builtin_amdgcn_rcpf(bf_hi(b.x)), bf_lo(a.y) * __builtin_amdgcn_rcpf(bf_lo(b.y)), bf_hi(a.y) * __builtin_amdgcn_rcpf(bf_hi(b.y))};
                const f32x4 r1 = {bf_lo(a.z) * __builtin_amdgcn_rcpf(bf_lo(b.z)), bf_hi(a.z) * __builtin_amdgcn_rcpf(bf_hi(b.z)), bf_lo(a.w) * __builtin_amdgcn_rcpf(bf_lo(b.w)), bf_hi(a.w) * __builtin_amdgcn_rcpf(bf_hi(b.w))};
                acc[ai][bj][m][0] *= r0; acc[ai][bj][m][1] *= r1; }
            asm volatile("" : "+v"(acc[ai][0][m][0]), "+v"(acc[ai][0][m][1]), "+v"(acc[ai][1][m][0]), "+v"(acc[ai][1][m][1]));
            asm volatile("" ::: "memory");
        EPI_ROWS_END
    }
    __device__ __forceinline__ void operator()(const f32x4 (&acc)[2][2][4][2], const Unit& u, int wr, int wc, int fr, int fq) const {
        const int col0 = u.pn * BM + wc * 32 + 8 * fq;
        EPI_ROWS_BEGIN
#pragma unroll
            for (int bj = 0; bj < 2; ++bj) { const u32x4 g = __builtin_nontemporal_load((const u32x4*)(GATES + (size_t)row * NGATE + DM + col0 + bj * HALF));
                const f32x4 g0 = {bf_lo(g.x), bf_hi(g.x), bf_lo(g.y), bf_hi(g.y)}, g1 = {bf_lo(g.z), bf_hi(g.z), bf_lo(g.w), bf_hi(g.w)};
                const f32x4 v0 = acc[ai][bj][m][0] * g0, v1 = acc[ai][bj][m][1] * g1;
                u32x4 w; w.x = cvt_pk_bf16(v0[0], v0[1]); w.y = cvt_pk_bf16(v0[2], v0[3]); w.z = cvt_pk_bf16(v1[0], v1[1]); w.w = cvt_pk_bf16(v1[2], v1[3]);
                *(u32x4*)(T + (size_t)row * DM + col0 + bj * HALF) = w; }
        EPI_ROWS_END
    }
};
struct EpiScaleBf16 {
    static constexpr bool PERM = true, HAS_MID = false;
    bf16_t* D; const float* gvec;
    __device__ __forceinline__ void operator()(const f32x4 (&acc)[2][2][4][2], const Unit& u, int wr, int wc, int fr, int fq) const {
        const int col0 = u.pn * BM + wc * 32 + 8 * fq;
        f32x4 gv[2][2];
#pragma unroll
        for (int bj = 0; bj < 2; ++bj)
#pragma unroll
            for (int n = 0; n < 2; ++n) gv[bj][n] = *(const f32x4*)(gvec + col0 + bj * HALF + 4 * n);
        EPI_ROWS_BEGIN
#pragma unroll
            for (int bj = 0; bj < 2; ++bj) { const f32x4 v0 = gv[bj][0] * acc[ai][bj][m][0], v1 = gv[bj][1] * acc[ai][bj][m][1];
                u32x4 w; w.x = cvt_pk_bf16(v0[0], v0[1]); w.y = cvt_pk_bf16(v0[2], v0[3]); w.z = cvt_pk_bf16(v1[0], v1[1]); w.w = cvt_pk_bf16(v1[2], v1[3]);
                *(u32x4*)(D + (size_t)row * DM + col0 + bj * HALF) = w; }
        EPI_ROWS_END
    }
};
struct EpiResid {
    static constexpr bool PERM = true, HAS_MID = false;
    const float* base; float* out; const float* gvec;
    __device__ __forceinline__ void operator()(const f32x4 (&acc)[2][2][4][2], const Unit& u, int wr, int wc, int fr, int fq) const {
        const int col0 = u.pn * BM + wc * 32 + 8 * fq;
        f32x4 gv[2][2];
#pragma unroll
        for (int bj = 0; bj < 2; ++bj)
#pragma unroll
            for (int n = 0; n < 2; ++n) gv[bj][n] = *(const f32x4*)(gvec + col0 + bj * HALF + 4 * n);
        EPI_ROWS_BEGIN
#pragma unroll
            for (int bj = 0; bj < 2; ++bj) { const size_t off = (size_t)row * DM + col0 + bj * HALF;
                const f32x4 b0 = __builtin_nontemporal_load((const f32x4*)(base + off)), b1 = __builtin_nontemporal_load((const f32x4*)(base + off + 4));
                __builtin_nontemporal_store(b0 + gv[bj][0] * acc[ai][bj][m][0], (f32x4*)(out + off)); __builtin_nontemporal_store(b1 + gv[bj][1] * acc[ai][bj][m][1], (f32x4*)(out + off + 4)); }
            if (m == 3) asm volatile("" ::: "memory");
        EPI_ROWS_END
    }
};
__device__ __forceinline__ f32x4 dpp_ror1(f32x4 v) { f32x4 r;
#pragma unroll
    for (int j = 0; j < 4; ++j) r[j] = __uint_as_float((unsigned)__builtin_amdgcn_update_dpp(0, (int)__float_as_uint(v[j]), 0x121, 0xF, 0xF, false)); return r; }
__device__ __forceinline__ f32x4 dpp_rol1(f32x4 v) { f32x4 r;
#pragma unroll
    for (int j = 0; j < 4; ++j) r[j] = __uint_as_float((unsigned)__builtin_amdgcn_update_dpp(0, (int)__float_as_uint(v[j]), 0x12F, 0xF, 0xF, false)); return r; }
struct EpiUpConv {
    static constexpr bool PERM = true, HAS_MID = false;
    bf16_t* HID; float* EA; float* EP; float* EU; const float* cw; const float* cb; PG8_LAS unsigned char* lds;
    __device__ __forceinline__ void operator()(const f32x4 (&acc)[2][2][4][2], const Unit& u, int wr, int wc, int fr, int fq) const {
        PG8_LAS float* EG = (PG8_LAS float*)(lds + EDGE_OFF);
        const int cl = wc * 32 + 8 * fq;
#pragma unroll
        for (int ai = 0; ai < 2; ++ai) { const int blk = 2 * ai + wr;
            if (fr == 0) {
#pragma unroll
                for (int n = 0; n < 2; ++n) *(PG8_LAS f32x4*)(EG + (blk * 2 + 0) * 128 + cl + 4 * n) = acc[ai][0][0][n]; }
            if (fr == 15) {
#pragma unroll
                for (int n = 0; n < 2; ++n) *(PG8_LAS f32x4*)(EG + (blk * 2 + 1) * 128 + cl + 4 * n) = acc[ai][0][3][n]; } }
        asm volatile("s_waitcnt lgkmcnt(0)" ::: "memory"); __builtin_amdgcn_s_barrier(); asm volatile("" ::: "memory");
        const int col = u.pn * HALF + cl;
        f32x4 w0[2], w1[2], w2[2], bb[2];
#pragma unroll
        for (int n = 0; n < 2; ++n) { w0[n] = *(const f32x4*)(cw + col + 4 * n); w1[n] = *(const f32x4*)(cw + DFF + col + 4 * n); w2[n] = *(const f32x4*)(cw + 2 * DFF + col + 4 * n); bb[n] = *(const f32x4*)(cb + col + 4 * n); }
        const f32x4 zero = {0.f, 0.f, 0.f, 0.f};
#pragma unroll
        for (int ai = 0; ai < 2; ++ai) { const int blk = 2 * ai + wr;
            f32x4 ep[2], en[2];
#pragma unroll
            for (int n = 0; n < 2; ++n) { ep[n] = blk > 0 ? *(const PG8_LAS f32x4*)(EG + ((blk - 1) * 2 + 1) * 128 + cl + 4 * n) : zero;
                                          en[n] = blk < 3 ? *(const PG8_LAS f32x4*)(EG + ((blk + 1) * 2 + 0) * 128 + cl + 4 * n) : zero; }
#pragma unroll
            for (int m = 0; m < 4; ++m) { const int rt = ai * HALF + wr * 64 + m * 16 + fr;
                const size_t row = (size_t)u.pm * BM + rt;
                f32x4 hv[2], cvv[2];
#pragma unroll
                for (int n = 0; n < 2; ++n) { const f32x4 cur = acc[ai][0][m][n];
                    const f32x4 rc = dpp_ror1(cur), lc = dpp_rol1(cur);
                    const f32x4 rp = m > 0 ? dpp_ror1(acc[ai][0][m > 0 ? m - 1 : 0][n]) : ep[n];
                    const f32x4 ln = m < 3 ? dpp_rol1(acc[ai][0][m < 3 ? m + 1 : 3][n]) : en[n];
                    const f32x4 prev = fr == 0 ? rp : rc, next = fr == 15 ? ln : lc;
                    const f32x4 cv = bb[n] + w0[n] * prev + w1[n] * cur + w2[n] * next; cvv[n] = cv;
                    f32x4 sg;
#pragma unroll
                    for (int j = 0; j < 4; ++j) sg[j] = __builtin_amdgcn_rcpf(1.0f + __builtin_amdgcn_exp2f(-cv[j] * LOG2E));
                    hv[n] = cv * sg * acc[ai][1][m][n]; }
                const bool edge = (rt == 0) || (rt == BM - 1);
                if (!edge) { u32x4 w; w.x = cvt_pk_bf16(hv[0][0], hv[0][1]); w.y = cvt_pk_bf16(hv[0][2], hv[0][3]); w.z = cvt_pk_bf16(hv[1][0], hv[1][1]); w.w = cvt_pk_bf16(hv[1][2], hv[1][3]);
                    *(u32x4*)(HID + row * DFF + col) = w; }
                else { const size_t eo = ((size_t)u.pm * 2 + (rt == 0 ? 0 : 1)) * DFF + col;
#pragma unroll
                    for (int n = 0; n < 2; ++n) { *(f32x4*)(EA + eo + 4 * n) = acc[ai][0][m][n]; *(f32x4*)(EP + eo + 4 * n) = cvv[n]; *(f32x4*)(EU + eo + 4 * n) = acc[ai][1][m][n]; } }
            } }
    }
};
}

namespace att {
constexpr int NW = 8, QBLK = 32, KVBLK = 64, LDR = NQKV;
constexpr size_t SHM_V = KVBLK * 128 * 2, SHM_K = KVBLK * 128 * 2;
constexpr size_t SHM_ATTN = 2 * SHM_V + 2 * SHM_K + NW * 64 * 4;
#define KSWZ(row, colB) ((row) * 256 + ((colB) ^ (((row) & 7) << 4)))
#define SBAR() __builtin_amdgcn_sched_barrier(0)
__device__ __forceinline__ int crow(int r, int hi) { return (r & 3) + 8 * (r >> 2) + 4 * hi; }
__device__ __forceinline__ int v_st(int k, int c) { const int kk = (k & ~0xC) | ((k & 4) << 1) | ((k & 8) >> 1); return ((kk >> 3) * 4 + (c >> 5)) * 512 + ((kk & 7) * 32 + (c & 31)) * 2; }
__device__ __forceinline__ int v_rd_base(int lane) { return ((lane & 3) << 3) | (((lane >> 2) & 3) << 6) | (((lane >> 4) & 1) << 5) | (((lane >> 5) & 1) << 8); }
constexpr int v_rd_off(int d0, int ks, int half) { return d0 * 512 + ks * 4096 + half * 2048; }
template <int OFF> __device__ __forceinline__ s16x4 tr_read(int vb) {
    s16x4 r; asm volatile("ds_read_b64_tr_b16 %0, %1 offset:%2" : "=&v"(r) : "v"(vb), "i"(OFF) : "memory"); return r;
}
template <int D0> __device__ __forceinline__ void pv_one(f32x16& od, int vb, bf16x8 pa0, bf16x8 pa1, bf16x8 pa2, bf16x8 pa3) {
    const s16x4 l0 = tr_read<v_rd_off(D0, 0, 0)>(vb), h0 = tr_read<v_rd_off(D0, 0, 1)>(vb), l1 = tr_read<v_rd_off(D0, 1, 0)>(vb), h1 = tr_read<v_rd_off(D0, 1, 1)>(vb);
    const s16x4 l2 = tr_read<v_rd_off(D0, 2, 0)>(vb), h2 = tr_read<v_rd_off(D0, 2, 1)>(vb), l3 = tr_read<v_rd_off(D0, 3, 0)>(vb), h3 = tr_read<v_rd_off(D0, 3, 1)>(vb);
    asm volatile("s_waitcnt lgkmcnt(0)" ::: "memory"); SBAR();
#define PK(L, H) (bf16x8){L[0], L[1], L[2], L[3], H[0], H[1], H[2], H[3]}
    od = __builtin_amdgcn_mfma_f32_32x32x16_bf16(pa0, PK(l0, h0), od, 0, 0, 0);
    od = __builtin_amdgcn_mfma_f32_32x32x16_bf16(pa1, PK(l1, h1), od, 0, 0, 0);
    od = __builtin_amdgcn_mfma_f32_32x32x16_bf16(pa2, PK(l2, h2), od, 0, 0, 0);
    od = __builtin_amdgcn_mfma_f32_32x32x16_bf16(pa3, PK(l3, h3), od, 0, 0, 0);
#undef PK
}
__device__ __forceinline__ void pv_d0(f32x16* o, int vb, bf16x8 pa0, bf16x8 pa1, bf16x8 pa2, bf16x8 pa3) {
    pv_one<0>(o[0], vb, pa0, pa1, pa2, pa3); pv_one<1>(o[1], vb, pa0, pa1, pa2, pa3); pv_one<2>(o[2], vb, pa0, pa1, pa2, pa3); pv_one<3>(o[3], vb, pa0, pa1, pa2, pa3);
}
__device__ __forceinline__ void partialSM(f32x16& p0) {
#pragma unroll
    for (int r = 0; r < 16; ++r) p0[r] = __builtin_amdgcn_exp2f(p0[r]);
}
__device__ __forceinline__ void finishSM(f32x16& p0, f32x16& p1, float& l_reg, bf16x8& pa0, bf16x8& pa1, bf16x8& pa2, bf16x8& pa3) {
#pragma unroll
    for (int r = 0; r < 16; ++r) p1[r] = __builtin_amdgcn_exp2f(p1[r]);
    float ps = 0;
#pragma unroll
    for (int r = 0; r < 16; ++r) ps += p0[r];
#pragma unroll
    for (int r = 0; r < 16; ++r) ps += p1[r];
    { auto rr = __builtin_amdgcn_permlane32_swap(__float_as_uint(ps), __float_as_uint(ps), false, false);
      ps = __uint_as_float(rr[0]) + __uint_as_float(rr[1]); }
    l_reg += ps;
#define PK4(P, BASE, OUT) do { unsigned a0 = cvt_pk_bf16(P[BASE + 0], P[BASE + 1]), a1 = cvt_pk_bf16(P[BASE + 2], P[BASE + 3]);   \
    unsigned b0 = cvt_pk_bf16(P[BASE + 4], P[BASE + 5]), b1 = cvt_pk_bf16(P[BASE + 6], P[BASE + 7]);                              \
    auto r0 = __builtin_amdgcn_permlane32_swap(a0, b0, false, false); auto r1 = __builtin_amdgcn_permlane32_swap(a1, b1, false, false); \
    u32x4 w = {r0[0], r1[0], r0[1], r1[1]}; OUT = *reinterpret_cast<bf16x8*>(&w); } while (0)
    PK4(p0, 0, pa0); PK4(p0, 8, pa1); PK4(p1, 0, pa2); PK4(p1, 8, pa3);
#undef PK4
}
__device__ __forceinline__ void qkt128(f32x16& p0, f32x16& p1, const char* Ks, const bf16x8* qr, int r32, int hi, float negm) {
#pragma unroll
    for (int r = 0; r < 16; ++r) { p0[r] = negm; p1[r] = negm; }
#pragma unroll
    for (int d0 = 0; d0 < 8; ++d0) { const int cb = (d0 * 16 + hi * 8) * 2;
        const bf16x8 b0 = *reinterpret_cast<const bf16x8*>(Ks + KSWZ(r32, cb));
        const bf16x8 b1 = *reinterpret_cast<const bf16x8*>(Ks + KSWZ(32 + r32, cb));
        p0 = __builtin_amdgcn_mfma_f32_32x32x16_bf16(b0, qr[d0], p0, 0, 0, 0);
        p1 = __builtin_amdgcn_mfma_f32_32x32x16_bf16(b1, qr[d0], p1, 0, 0, 0); }
}
__device__ __forceinline__ void qkt64(f32x16& p0, f32x16& p1, const char* Ks, const bf16x8* qr, int r32, int hi, float negm) {
#pragma unroll
    for (int r = 0; r < 16; ++r) { p0[r] = negm; p1[r] = negm; }
    const char* kb = Ks + hi * 1024 + r32 * 16;
#pragma unroll
    for (int d0 = 0; d0 < 4; ++d0) {
        const bf16x8 b0 = *reinterpret_cast<const bf16x8*>(kb + d0 * 2048);
        const bf16x8 b1 = *reinterpret_cast<const bf16x8*>(kb + d0 * 2048 + 512);
        p0 = __builtin_amdgcn_mfma_f32_32x32x16_bf16(b0, qr[d0], p0, 0, 0, 0);
        p1 = __builtin_amdgcn_mfma_f32_32x32x16_bf16(b1, qr[d0], p1, 0, 0, 0); }
}
__device__ __forceinline__ void wmask(f32x16& p0, f32x16& p1, int k0, int qpos, int hi) {
#pragma unroll
    for (int r = 0; r < 16; ++r) { const int kv = k0 + crow(r, hi); int d0 = kv - qpos; d0 = d0 < 0 ? -d0 : d0; int d1 = kv + 32 - qpos; d1 = d1 < 0 ? -d1 : d1;
        if (d0 > 128) p0[r] = -INFINITY; if (d1 > 128) p1[r] = -INFINITY; }
}

#define PIN(x) asm volatile("" : "+v"(x))
__device__ __forceinline__ void qkt64_fin(f32x16& c0, f32x16& c1, const char* Ks, const bf16x8* qr, int r32, int hi, float negm,
                                          const f32x16& p0, const f32x16& p1, float& l_reg, bf16x8& pa0, bf16x8& pa1, bf16x8& pa2, bf16x8& pa3) {
#pragma unroll
    for (int r = 0; r < 16; ++r) { c0[r] = negm; c1[r] = negm; }
    const char* kb = Ks + hi * 1024 + r32 * 16;
    bf16x8 kf[8];
#pragma unroll
    for (int d0 = 0; d0 < 4; ++d0) { kf[2 * d0] = *reinterpret_cast<const bf16x8*>(kb + d0 * 2048); kf[2 * d0 + 1] = *reinterpret_cast<const bf16x8*>(kb + d0 * 2048 + 512); }
    float sacc = 0.f; unsigned a0, a1, b0, b1; u32x4 w;
#define QF_GAP_A(MF, P, B) do { MF; sacc += P[B]; sacc += P[B + 1]; sacc += P[B + 2]; sacc += P[B + 3]; PIN(sacc); a0 = cvt_pk_bf16(P[B], P[B + 1]); a1 = cvt_pk_bf16(P[B + 2], P[B + 3]); PIN(a0); PIN(a1); SBAR(); } while (0)
#define QF_GAP_B(MF, P, B, OUT) do { MF; sacc += P[B]; sacc += P[B + 1]; sacc += P[B + 2]; sacc += P[B + 3]; PIN(sacc); b0 = cvt_pk_bf16(P[B], P[B + 1]); b1 = cvt_pk_bf16(P[B + 2], P[B + 3]); \
        { auto r0 = __builtin_amdgcn_permlane32_swap(a0, b0, false, false); auto r1 = __builtin_amdgcn_permlane32_swap(a1, b1, false, false); w = (u32x4){r0[0], r1[0], r0[1], r1[1]}; } \
        OUT = *reinterpret_cast<bf16x8*>(&w); PIN(OUT); SBAR(); } while (0)
    SBAR();
    QF_GAP_A(c0 = __builtin_amdgcn_mfma_f32_32x32x16_bf16(kf[0], qr[0], c0, 0, 0, 0), p0, 0);
    QF_GAP_B(c1 = __builtin_amdgcn_mfma_f32_32x32x16_bf16(kf[1], qr[0], c1, 0, 0, 0), p0, 4, pa0);
    QF_GAP_A(c0 = __builtin_amdgcn_mfma_f32_32x32x16_bf16(kf[2], qr[1], c0, 0, 0, 0), p0, 8);
    QF_GAP_B(c1 = __builtin_amdgcn_mfma_f32_32x32x16_bf16(kf[3], qr[1], c1, 0, 0, 0), p0, 12, pa1);
    QF_GAP_A(c0 = __builtin_amdgcn_mfma_f32_32x32x16_bf16(kf[4], qr[2], c0, 0, 0, 0), p1, 0);
    QF_GAP_B(c1 = __builtin_amdgcn_mfma_f32_32x32x16_bf16(kf[5], qr[2], c1, 0, 0, 0), p1, 4, pa2);
    QF_GAP_A(c0 = __builtin_amdgcn_mfma_f32_32x32x16_bf16(kf[6], qr[3], c0, 0, 0, 0), p1, 8);
    QF_GAP_B(c1 = __builtin_amdgcn_mfma_f32_32x32x16_bf16(kf[7], qr[3], c1, 0, 0, 0), p1, 12, pa3);
#undef QF_GAP_A
#undef QF_GAP_B
    { auto rr = __builtin_amdgcn_permlane32_swap(__float_as_uint(sacc), __float_as_uint(sacc), false, false); sacc = __uint_as_float(rr[0]) + __uint_as_float(rr[1]); }
    l_reg += sacc;
}
__device__ __forceinline__ void fin_only(const f32x16& p0, const f32x16& p1, float& l_reg, bf16x8& pa0, bf16x8& pa1, bf16x8& pa2, bf16x8& pa3) {
    float ps = 0;
#pragma unroll
    for (int r = 0; r < 16; ++r) ps += p0[r];
#pragma unroll
    for (int r = 0; r < 16; ++r) ps += p1[r];
    { auto rr = __builtin_amdgcn_permlane32_swap(__float_as_uint(ps), __float_as_uint(ps), false, false); ps = __uint_as_float(rr[0]) + __uint_as_float(rr[1]); }
    l_reg += ps;
#define PK4(P, BASE, OUT) do { unsigned a0 = cvt_pk_bf16(P[BASE + 0], P[BASE + 1]), a1 = cvt_pk_bf16(P[BASE + 2], P[BASE + 3]);   \
    unsigned b0 = cvt_pk_bf16(P[BASE + 4], P[BASE + 5]), b1 = cvt_pk_bf16(P[BASE + 6], P[BASE + 7]);                              \
    auto r0 = __builtin_amdgcn_permlane32_swap(a0, b0, false, false); auto r1 = __builtin_amdgcn_permlane32_swap(a1, b1, false, false); \
    u32x4 w = {r0[0], r1[0], r0[1], r1[1]}; OUT = *reinterpret_cast<bf16x8*>(&w); } while (0)
    PK4(p0, 0, pa0); PK4(p0, 8, pa1); PK4(p1, 0, pa2); PK4(p1, 8, pa3);
#undef PK4
}
#define PV_RD(D0, L, H) do { L[0] = tr_read<v_rd_off(D0, 0, 0)>(vb); H[0] = tr_read<v_rd_off(D0, 0, 1)>(vb); L[1] = tr_read<v_rd_off(D0, 1, 0)>(vb); H[1] = tr_read<v_rd_off(D0, 1, 1)>(vb); \
    L[2] = tr_read<v_rd_off(D0, 2, 0)>(vb); H[2] = tr_read<v_rd_off(D0, 2, 1)>(vb); L[3] = tr_read<v_rd_off(D0, 3, 0)>(vb); H[3] = tr_read<v_rd_off(D0, 3, 1)>(vb); } while (0)
#define PV_PK(L, H, k) (bf16x8){L[k][0], L[k][1], L[k][2], L[k][3], H[k][0], H[k][1], H[k][2], H[k][3]}
#define PV_MM(OD, L, H) do { OD = __builtin_amdgcn_mfma_f32_32x32x16_bf16(pa0, PV_PK(L, H, 0), OD, 0, 0, 0); OD = __builtin_amdgcn_mfma_f32_32x32x16_bf16(pa1, PV_PK(L, H, 1), OD, 0, 0, 0); \
    OD = __builtin_amdgcn_mfma_f32_32x32x16_bf16(pa2, PV_PK(L, H, 2), OD, 0, 0, 0); OD = __builtin_amdgcn_mfma_f32_32x32x16_bf16(pa3, PV_PK(L, H, 3), OD, 0, 0, 0); } while (0)
__device__ __forceinline__ void pv_pipe(f32x16* o, int vb, bf16x8 pa0, bf16x8 pa1, bf16x8 pa2, bf16x8 pa3) {
    s16x4 la[4], ha[4], lb[4], hb[4];
    PV_RD(0, la, ha); PV_RD(1, lb, hb);
    asm volatile("s_waitcnt lgkmcnt(8)" ::: "memory"); SBAR(); PV_MM(o[0], la, ha); SBAR();
    PV_RD(2, la, ha);
    asm volatile("s_waitcnt lgkmcnt(8)" ::: "memory"); SBAR(); PV_MM(o[1], lb, hb); SBAR();
    PV_RD(3, lb, hb);
    asm volatile("s_waitcnt lgkmcnt(8)" ::: "memory"); SBAR(); PV_MM(o[2], la, ha); SBAR();
    asm volatile("s_waitcnt lgkmcnt(0)" ::: "memory"); SBAR(); PV_MM(o[3], lb, hb);
}
#define PV_MX(OD, L, H, C, E) do { \
    OD = __builtin_amdgcn_mfma_f32_32x32x16_bf16(pa0, PV_PK(L, H, 0), OD, 0, 0, 0); C[E + 0] = __builtin_amdgcn_exp2f(C[E + 0]); C[E + 1] = __builtin_amdgcn_exp2f(C[E + 1]); PIN(C); SBAR(); \
    OD = __builtin_amdgcn_mfma_f32_32x32x16_bf16(pa1, PV_PK(L, H, 1), OD, 0, 0, 0); C[E + 2] = __builtin_amdgcn_exp2f(C[E + 2]); C[E + 3] = __builtin_amdgcn_exp2f(C[E + 3]); PIN(C); SBAR(); \
    OD = __builtin_amdgcn_mfma_f32_32x32x16_bf16(pa2, PV_PK(L, H, 2), OD, 0, 0, 0); C[E + 4] = __builtin_amdgcn_exp2f(C[E + 4]); C[E + 5] = __builtin_amdgcn_exp2f(C[E + 5]); PIN(C); SBAR(); \
    OD = __builtin_amdgcn_mfma_f32_32x32x16_bf16(pa3, PV_PK(L, H, 3), OD, 0, 0, 0); C[E + 6] = __builtin_amdgcn_exp2f(C[E + 6]); C[E + 7] = __builtin_amdgcn_exp2f(C[E + 7]); PIN(C); SBAR(); } while (0)
__device__ __forceinline__ void pv_pipe_exp(f32x16* o, int vb, bf16x8 pa0, bf16x8 pa1, bf16x8 pa2, bf16x8 pa3, f32x16& c0, f32x16& c1) {
    s16x4 la[4], ha[4], lb[4], hb[4];
    PV_RD(0, la, ha); PV_RD(1, lb, hb);
    asm volatile("s_waitcnt lgkmcnt(8)" ::: "memory"); SBAR(); PV_MX(o[0], la, ha, c0, 0);
    PV_RD(2, la, ha);
    asm volatile("s_waitcnt lgkmcnt(8)" ::: "memory"); SBAR(); PV_MX(o[1], lb, hb, c0, 8);
    PV_RD(3, lb, hb);
    asm volatile("s_waitcnt lgkmcnt(8)" ::: "memory"); SBAR(); PV_MX(o[2], la, ha, c1, 0);
    asm volatile("s_waitcnt lgkmcnt(0)" ::: "memory"); SBAR(); PV_MX(o[3], lb, hb, c1, 8);
}
#undef PV_MX
#undef PV_RD
#undef PV_PK
#undef PV_MM

template <bool WA>
__device__ __forceinline__ void attn_unit(const bf16_t* __restrict__ Qb, const bf16_t* __restrict__ Kh, const bf16_t* __restrict__ Vh,
                                          float* __restrict__ Of, bf16_t* __restrict__ Ob, int ldo,
                                          int NT, int kstart, int nb, int q0, float negm, float l_init, char* lds,
                                          const float* __restrict__ qg, const float* __restrict__ ropetab, float qscale,
                                          bool combine = false, float lam = 0.f, const float* __restrict__ subg = nullptr, bf16_t* __restrict__ Yo = nullptr, int ldy = 0) {
    constexpr int NQ = WA ? 8 : 4;
    constexpr int SLOT_V = 16384, SLOT_K = WA ? 16384 : 8192;
    const int tid = opq(threadIdx.x), wid = __builtin_amdgcn_readfirstlane(tid >> 6), lane = tid & 63, r32 = lane & 31, hi = lane >> 5;
    constexpr int RING = WA ? 3 : 5;
    char* V_lds = lds; char* K_lds = lds + RING * SLOT_V;
    float* ws = (float*)(lds + RING * SLOT_V + RING * SLOT_K) + wid * 64; float* li_l = ws;
    float l_reg = l_init; f32x16 o[4] = {}; bf16x8 qr[NQ];
    const int wrow = WA ? (wid & 1) * QBLK : wid * QBLK, wcol = WA ? (wid >> 1) * 128 : 0;
    const bf16_t* Qw = Qb + (long)(wrow + r32) * LDR + wcol + hi * 8;
#pragma unroll
    for (int d0 = 0; d0 < NQ; ++d0) qr[d0] = __builtin_nontemporal_load(reinterpret_cast<const bf16x8*>(Qw + d0 * 16));
    {
        constexpr int HD = WA ? 128 : 64, QD = HD / 4;
        const int qrow = q0 + wrow + r32;
        float v[NQ][8]; float ss = 0.f;
#pragma unroll
        for (int d0 = 0; d0 < NQ; ++d0) { const u32x4 raw = __builtin_bit_cast(u32x4, qr[d0]);
            v[d0][0] = bf_lo(raw.x); v[d0][1] = bf_hi(raw.x); v[d0][2] = bf_lo(raw.y); v[d0][3] = bf_hi(raw.y); v[d0][4] = bf_lo(raw.z); v[d0][5] = bf_hi(raw.z); v[d0][6] = bf_lo(raw.w); v[d0][7] = bf_hi(raw.w);
#pragma unroll
            for (int j = 0; j < 8; ++j) ss += v[d0][j] * v[d0][j]; }
        ss += shx(ss, 32, lane);
        const float rstd = 1.0f / sqrtf(ss * (1.f / HD) + EPS);
#pragma unroll
        for (int d0 = 0; d0 < NQ; ++d0) { const float* gp = qg + 16 * d0 + 8 * hi; const f32x4 g0 = *(const f32x4*)gp, g1 = *(const f32x4*)(gp + 4);
            const float gg[8] = {g0.x, g0.y, g0.z, g0.w, g1.x, g1.y, g1.z, g1.w};
#pragma unroll
            for (int j = 0; j < 8; ++j) v[d0][j] = v[d0][j] * rstd * gg[j]; }
#pragma unroll
        for (int d0 = 0; d0 < NQ; ++d0) {
            const int axis = WA ? (d0 >> 2) : (d0 >> 1), fi0 = (WA ? 16 * (d0 & 1) : 0) + 8 * hi, dp = WA ? (d0 ^ 2) : (d0 ^ 1); const bool second = WA ? ((d0 & 2) != 0) : ((d0 & 1) != 0);
            const int pos = axis == 0 ? (qrow >> 6) : (qrow & 63);
            const float* cp = ropetab + pos * QD + fi0; const float* sp = ropetab + 256 * QD + pos * QD + fi0;
            const f32x4 c0 = *(const f32x4*)cp, c1 = *(const f32x4*)(cp + 4), s0 = *(const f32x4*)sp, s1 = *(const f32x4*)(sp + 4);
            const float cc[8] = {c0.x, c0.y, c0.z, c0.w, c1.x, c1.y, c1.z, c1.w}, sn[8] = {s0.x, s0.y, s0.z, s0.w, s1.x, s1.y, s1.z, s1.w};
            float w[8];
#pragma unroll
            for (int j = 0; j < 8; ++j) w[j] = (second ? (v[d0][j] * cc[j] + v[dp][j] * sn[j]) : (v[d0][j] * cc[j] - v[dp][j] * sn[j])) * qscale;
            u32x4 o4; o4.x = cvt_pk_bf16(w[0], w[1]); o4.y = cvt_pk_bf16(w[2], w[3]); o4.z = cvt_pk_bf16(w[4], w[5]); o4.w = cvt_pk_bf16(w[6], w[7]);
            qr[d0] = __builtin_bit_cast(bf16x8, o4); }
    }
    const int sr = tid >> 4, sc = (tid & 15) * 8, vst0 = v_st(sr, sc), vst1 = v_st(32 + sr, sc);
    const int vb0 = (int)(uintptr_t)V_lds + v_rd_base(lane);
    const int qpos = q0 + wrow + r32;
    bf16x8 vs0, vs1, ks0, ks1;
#define KOFF(j) ((j) < nb ? kstart + (j) * KVBLK : SEQ + ((j) - nb) * KVBLK)
#define SLOADX(jt, A0, A1, B0, B1) do { const int k0_ = KOFF(jt); \
    A0 = *reinterpret_cast<const bf16x8*>(&Vh[(long)(k0_ + sr) * LDR + sc]); A1 = *reinterpret_cast<const bf16x8*>(&Vh[(long)(k0_ + 32 + sr) * LDR + sc]); \
    if (WA) { B0 = *reinterpret_cast<const bf16x8*>(&Kh[(long)(k0_ + sr) * LDR + sc]); B1 = *reinterpret_cast<const bf16x8*>(&Kh[(long)(k0_ + 32 + sr) * LDR + sc]); } \
    else { B0 = *reinterpret_cast<const bf16x8*>(&Kh[(long)(k0_ + lane) * LDR + wid * 8]); } } while (0)
#define SWRITEX(sv, sk, A0, A1, B0, B1) do { *(bf16x8*)(V_lds + (sv) + vst0) = A0; *(bf16x8*)(V_lds + (sv) + vst1) = A1; \
    if (WA) { const int kc = sc * 2; *(bf16x8*)(K_lds + (sk) + KSWZ(sr, kc)) = B0; *(bf16x8*)(K_lds + (sk) + KSWZ(32 + sr, kc)) = B1; } \
    else { *(bf16x8*)(K_lds + (sk) + wid * 1024 + lane * 16) = B0; } } while (0)
#define SLOAD(jt) SLOADX(jt, vs0, vs1, ks0, ks1)
#define SWRITE(sv, sk) SWRITEX(sv, sk, vs0, vs1, ks0, ks1)
#define QKT(P0, P1, sk) do { if (WA) qkt128(P0, P1, K_lds + (sk), qr, r32, hi, negm); else qkt64(P0, P1, K_lds + (sk), qr, r32, hi, negm); } while (0)
#define MASK(P0, P1, jt) do { if (WA) { if ((jt) < nb) wmask(P0, P1, kstart + (jt) * KVBLK, qpos, hi); } } while (0)
#define PVS(sv) do { if (WA) pv_d0(o, vb0 + (sv), pa0, pa1, pa2, pa3); else pv_pipe(o, vb0 + (sv), pa0, pa1, pa2, pa3); } while (0)
    f32x16 pA0, pA1, pB0, pB1; bf16x8 pa0, pa1, pa2, pa3;
    if (WA) {
    int s_prev = 2, s_cur = 0, s_next = 1;
#define ROT() do { const int t_ = s_prev; s_prev = s_cur; s_cur = s_next; s_next = t_; } while (0)
    { bf16x8 xa0, xa1, xb0, xb1; SLOADX(0, xa0, xa1, xb0, xb1); SLOAD(1); SWRITEX(0, 0, xa0, xa1, xb0, xb1); }
    __syncthreads();
    QKT(pA0, pA1, 0); MASK(pA0, pA1, 0); partialSM(pA0);
    SWRITE(SLOT_V, SLOT_K); if (2 < NT) SLOAD(2);
    __syncthreads(); ROT();
#define STEP(PC0, PC1, PP0, PP1, j) do { \
        if ((j) + 1 < NT) { SWRITE(s_next * SLOT_V, s_next * SLOT_K); } if ((j) + 2 < NT) { SLOAD((j) + 2); } \
        SBAR(); QKT(PC0, PC1, s_cur * SLOT_K); MASK(PC0, PC1, j); \
        finishSM(PP0, PP1, l_reg, pa0, pa1, pa2, pa3); SBAR(); \
        PVS(s_prev * SLOT_V); partialSM(PC0); \
        __syncthreads(); ROT(); } while (0)
    int js = 1;
    for (; js + 1 < NT; js += 2) { STEP(pB0, pB1, pA0, pA1, js); STEP(pA0, pA1, pB0, pB1, js + 1); }
    if (js < NT) { STEP(pB0, pB1, pA0, pA1, js); }
    else { pB0 = pA0; pB1 = pA1; }
    finishSM(pB0, pB1, l_reg, pa0, pa1, pa2, pa3); SBAR(); PVS(s_prev * SLOT_V);
#undef STEP
#undef ROT
    } else {
    int s_pv = 4, s_qk = 0, s_wr = 2;
#define ADV() do { s_pv = s_pv == 4 ? 0 : s_pv + 1; s_qk = s_qk == 4 ? 0 : s_qk + 1; s_wr = s_wr == 4 ? 0 : s_wr + 1; } while (0)
    { bf16x8 xa0, xa1, xb0, xb1, ya0, ya1, yb0, yb1; SLOADX(0, xa0, xa1, xb0, xb1); SLOADX(1, ya0, ya1, yb0, yb1); SLOAD(2);
      SWRITEX(0, 0, xa0, xa1, xb0, xb1); SWRITEX(SLOT_V, SLOT_K, ya0, ya1, yb0, yb1); }
    __syncthreads();
    SWRITE(2 * SLOT_V, 2 * SLOT_K); if (3 < NT) SLOAD(3);
    QKT(pA0, pA1, 0); partialSM(pA0); partialSM(pA1);
    ADV();
#define ITER(PC0, PC1, PP0, PP1, j, BARRIER) do { \
        if ((wid >> 2) == ((BARRIER) ? 0 : 1)) __builtin_amdgcn_s_setprio(1); else __builtin_amdgcn_s_setprio(0);     \
        if ((j) + 2 < NT) { SWRITE(s_wr * SLOT_V, s_wr * SLOT_K); } if ((j) + 3 < NT) { SLOAD((j) + 3); } \
        qkt64_fin(PC0, PC1, K_lds + s_qk * SLOT_K, qr, r32, hi, negm, PP0, PP1, l_reg, pa0, pa1, pa2, pa3); \
        pv_pipe_exp(o, vb0 + s_pv * SLOT_V, pa0, pa1, pa2, pa3, PC0, PC1); \
        if (BARRIER) __syncthreads(); \
        ADV(); } while (0)
    for (int j = 1; j + 1 < NT; j += 2) { ITER(pB0, pB1, pA0, pA1, j, true); ITER(pA0, pA1, pB0, pB1, j + 1, false); }
    ITER(pB0, pB1, pA0, pA1, NT - 1, false);
    __builtin_amdgcn_s_setprio(0);
    fin_only(pB0, pB1, l_reg, pa0, pa1, pa2, pa3); SBAR(); pv_pipe(o, vb0 + s_pv * SLOT_V, pa0, pa1, pa2, pa3);
#undef ITER
#undef ADV
    }
    if (hi == 0) li_l[r32] = l_reg; asm volatile("s_waitcnt lgkmcnt(0)" ::: "memory");
    float rli[16];
#pragma unroll
    for (int r = 0; r < 16; ++r) rli[r] = __builtin_amdgcn_rcpf(li_l[crow(r, hi)]);
    if (WA) {
        bf16_t* Ow = Ob + (long)wrow * ldo + wcol;
#pragma unroll
        for (int r = 0; r < 16; ++r) { const int orow = crow(r, hi);
#pragma unroll
            for (int d0 = 0; d0 < 4; ++d0) { const unsigned w = cvt_pk_bf16(o[d0][r] * rli[r], 0.f); Ow[(long)orow * ldo + d0 * 32 + r32] = (bf16_t)(w & 0xffffu); } }
    } else if (!combine) {
        float* Ow = Of + (long)(wid * QBLK) * ldo;
#pragma unroll
        for (int r = 0; r < 16; ++r) { const int orow = crow(r, hi);
#pragma unroll
            for (int d0 = 0; d0 < 4; ++d0) Ow[(long)orow * ldo + d0 * 32 + r32] = o[d0][r] * rli[r]; }
    } else {
        const float* Ow = Of + (long)(wid * QBLK) * ldo;
        float gsub[4];
#pragma unroll
        for (int d0 = 0; d0 < 4; ++d0) gsub[d0] = subg[d0 * 32 + r32] * 0.8f;
        bf16_t* Yw = Yo + (long)(wid * QBLK) * ldy;
#pragma unroll
        for (int r = 0; r < 16; ++r) { const int orow = crow(r, hi);
            float d[4]; float ss = 0.f;
#pragma unroll
            for (int d0 = 0; d0 < 4; ++d0) { d[d0] = Ow[(long)orow * ldo + d0 * 32 + r32] - lam * (o[d0][r] * rli[r]); ss += d[d0] * d[d0]; }
            ss += shx(ss, 1, lane); ss += shx(ss, 2, lane); ss += shx(ss, 4, lane); ss += shx(ss, 8, lane); ss += shx(ss, 16, lane);
            const float rs = 1.0f / sqrtf(ss * (1.f / 128.f) + EPS);
#pragma unroll
            for (int d0 = 0; d0 < 4; ++d0) { const unsigned w = cvt_pk_bf16(d[d0] * rs * gsub[d0], 0.f); Yw[(long)orow * ldy + d0 * 32 + r32] = (bf16_t)(w & 0xffffu); } }
    }
    __syncthreads();
#undef KOFF
#undef SLOAD
#undef SLOADX
#undef SWRITEX
#undef SWRITE
#undef QKT
#undef MASK
#undef PVS
#undef ROT
#undef STEP
}
#undef SBAR
}

#define XB_TMO      128
#define XB_XCNT(j)  (256  + 64 * (j))
#define XB_XSUB(j)  (1280 + 64 * (j))
#define XB_XGEN(j)  (2304 + 64 * (j))
#define XB_TOP      3328
#define XB_TOPGEN   3392
#define XCD_BAR_WORDS 3456
#define XB_SPIN_CAP (1u << 18)
static_assert((size_t)(CW_BAR + XCD_BAR_WORDS) * 4 <= CTL_ZERO_BYTES, "the per-call memset must cover every barrier word");
__device__ __forceinline__ unsigned xb_ld(unsigned* p)              { return __hip_atomic_load(p, __ATOMIC_RELAXED, __HIP_MEMORY_SCOPE_AGENT); }
__device__ __forceinline__ unsigned xb_add(unsigned* p, unsigned v) { return __hip_atomic_fetch_add(p, v, __ATOMIC_RELAXED, __HIP_MEMORY_SCOPE_AGENT); }
__device__ __forceinline__ unsigned xb_xcc_id() { return (unsigned)__builtin_amdgcn_s_getreg((3 << 11) | 20) & 0xFu; }
#define XB_SPIN(cond, bar) do { unsigned _sp = 0; while (cond) { __builtin_amdgcn_s_sleep(1); \
    if ((++_sp & 255u) == 0u) { if (xb_ld(&(bar)[XB_TMO])) break; if (_sp > XB_SPIN_CAP) { atomicAdd(&(bar)[XB_TMO], 1u); break; } } } } while (0)
struct XcdBarrier { unsigned* bar; unsigned x; volatile LAS unsigned* st; };
__device__ __forceinline__ XcdBarrier xcd_barrier_post(unsigned* bar, volatile LAS unsigned* st) {
    XcdBarrier b; b.bar = bar; b.x = xb_xcc_id(); b.st = st;
    if (threadIdx.x == 0) (void)xb_add(&bar[XB_XCNT(b.x)], 1u);
    return b;
}
__device__ __forceinline__ void xcd_barrier_complete(unsigned* bar, unsigned x, unsigned& nloc, unsigned& nx) {
    const unsigned G = gridDim.x * gridDim.y * gridDim.z;
    unsigned sum, cnt, mine, sp = 0u;
    for (;;) {
        sum = 0u; cnt = 0u; mine = 0u;
#pragma unroll
        for (unsigned j = 0; j < 16; ++j) { const unsigned c = xb_ld(&bar[XB_XCNT(j)]); sum += c; cnt += (c > 0u) ? 1u : 0u; mine = (j == x) ? c : mine; }
        if (sum == G) break;
        __builtin_amdgcn_s_sleep(1);
        if ((++sp & 255u) == 0u) { if (xb_ld(&bar[XB_TMO])) break; if (sp > XB_SPIN_CAP) { atomicAdd(&bar[XB_TMO], 1u); break; } }
    }
    nloc = mine > 0u ? mine : 1u; nx = cnt > 0u ? cnt : 1u;
}
__device__ __forceinline__ void xcd_barrier(const XcdBarrier& b) {
    asm volatile("s_waitcnt vmcnt(0)" ::: "memory");
    __syncthreads();
    if (threadIdx.x == 0) {
        unsigned* bar = b.bar;
        __builtin_amdgcn_s_waitcnt(0);
        unsigned nloc = b.st[0], nx = b.st[1];
        if (nloc == 0u) { xcd_barrier_complete(bar, b.x, nloc, nx); b.st[0] = nloc; b.st[1] = nx; }
        const unsigned old = xb_add(&bar[XB_XSUB(b.x)], 1u);
        const unsigned gen = old / nloc;
        if (old + 1u == (gen + 1u) * nloc) {
            __builtin_amdgcn_fence(__ATOMIC_RELEASE, "agent");
            asm volatile("s_waitcnt vmcnt(0)" ::: "memory");
            const unsigned og = xb_add(&bar[XB_TOP], 1u);
            const unsigned tg = og / nx;
            if (og + 1u == (tg + 1u) * nx) xb_add(&bar[XB_TOPGEN], 1u);
            else XB_SPIN(xb_ld(&bar[XB_TOPGEN]) == tg, bar);
            __builtin_amdgcn_fence(__ATOMIC_ACQUIRE, "agent");
            xb_add(&bar[XB_XGEN(b.x)], 1u);
            asm volatile("s_waitcnt vmcnt(0)" ::: "memory");
        } else {
            XB_SPIN(xb_ld(&bar[XB_XGEN(b.x)]) == gen, bar);
            __builtin_amdgcn_fence(__ATOMIC_ACQUIRE, "agent");
            asm volatile("s_waitcnt vmcnt(0)" ::: "memory");
        }
    }
    __syncthreads();
}

struct Args {
    const float* in[27];
    float* out;
    unsigned char* ws;
};
enum { I_X = 0, I_C, I_CTX, I_CCTX, I_WADA, I_BADA, I_ANG, I_WIN, I_BGATE, I_DAQG, I_DAKG, I_LQ1, I_LK1, I_LQ2, I_LK2, I_SUBG, I_WAQG, I_WAKG, I_SINK,
       I_WODA, I_WOWA, I_WOUT, I_FNG, I_WUP, I_CONVW, I_CONVB, I_WDN };
enum { V_A1 = 0, V_B1, V_A1C, V_B1C, V_G1, V_A2, V_B2, V_G2 };

template <bool NTST = false>
__device__ __forceinline__ void transpose_item(const float* W, int K, int N, bf16_t* WT, int k0, int n0, int orow0, LAS float* scr, int lane, int ldw = 0, int kofs = 0) {
    if (ldw == 0) ldw = K;
#pragma unroll 8
    for (int i = 0; i < 32; ++i) { const int kk = 2 * i + (lane >> 5); scr[kk * 33 + (lane & 31)] = __builtin_nontemporal_load(&W[(size_t)(k0 + kk) * N + n0 + (lane & 31)]); }
    LDS_WAIT(); asm volatile("" ::: "memory");
    const int c = lane & 7;
#pragma unroll
    for (int j = 0; j < 4; ++j) { const int n = (lane >> 3) + 8 * j; const LAS float* s = scr + (8 * c) * 33 + n;
        u32x4 o; o.x = cvt_pk_bf16(s[0 * 33], s[1 * 33]); o.y = cvt_pk_bf16(s[2 * 33], s[3 * 33]); o.z = cvt_pk_bf16(s[4 * 33], s[5 * 33]); o.w = cvt_pk_bf16(s[6 * 33], s[7 * 33]);
        if (NTST) __builtin_nontemporal_store(o, (GAS u32x4*)(WT + (size_t)(orow0 + n) * ldw + kofs + k0 + 8 * c)); else *(GAS u32x4*)(WT + (size_t)(orow0 + n) * ldw + kofs + k0 + 8 * c) = o; }
    LDS_WAIT(); asm volatile("" ::: "memory");
}

__device__ __forceinline__ void rms_mod_row(const float* xrow, const float* Av, const float* Bv, bf16_t* orow, int lane, const bf16_t* add = nullptr, float* sumrow = nullptr) {
    const GAS f32x4* xr = (const GAS f32x4*)xrow + lane;
    f32x4 v[16]; float s = 0.f;
    if (add) {
        const GAS u32x2* ar = (const GAS u32x2*)add + lane; GAS f32x4* sr = (GAS f32x4*)sumrow + lane;
#pragma unroll
        for (int j = 0; j < 16; ++j) { const u32x2 a = __builtin_nontemporal_load(&ar[64 * j]); v[j] = __builtin_nontemporal_load(&xr[64 * j]); v[j].x += bf_lo(a.x); v[j].y += bf_hi(a.x); v[j].z += bf_lo(a.y); v[j].w += bf_hi(a.y); __builtin_nontemporal_store(v[j], &sr[64 * j]);
            s += (v[j].x * v[j].x + v[j].y * v[j].y) + (v[j].z * v[j].z + v[j].w * v[j].w); }
    } else
#pragma unroll
    for (int j = 0; j < 16; ++j) { v[j] = __builtin_nontemporal_load(&xr[64 * j]); s += (v[j].x * v[j].x + v[j].y * v[j].y) + (v[j].z * v[j].z + v[j].w * v[j].w); }
    const float rstd = 1.0f / sqrtf(wave_sum(s, lane) * (1.f / DM) + EPS);
    GAS u32x2* o8 = (GAS u32x2*)orow + lane;
    const GAS f32x4* a4 = (const GAS f32x4*)Av + lane; const GAS f32x4* b4 = (const GAS f32x4*)Bv + lane;
#pragma unroll
    for (int j = 0; j < 16; ++j) { const f32x4 a = a4[64 * j], b = b4[64 * j]; const f32x4 y = v[j] * rstd * a + b;
        u32x2 w; w.x = cvt_pk_bf16(y.x, y.y); w.y = cvt_pk_bf16(y.z, y.w); o8[64 * j] = w; }
}

__device__ __forceinline__ float max_abs64(const float* g, int n, int lane) {
    float m = fabsf(g[lane]); if (n > 64) m = fmaxf(m, fabsf(g[64 + lane]));
#pragma unroll
    for (int o = 1; o < 64; o <<= 1) m = fmaxf(m, shx(m, o, lane));
    return m;
}

__global__ void __launch_bounds__(NWAVES * 64, 2) fwd_kernel(Args args) {
    extern __shared__ __attribute__((aligned(16))) unsigned char lds[];
    LAS unsigned char* ldsl = (LAS unsigned char*)lds;
    volatile LAS unsigned* MISC = (volatile LAS unsigned*)(ldsl + MISC_OFF);
    const int wave = __builtin_amdgcn_readfirstlane((int)threadIdx.x >> 6);
    const int G = gridDim.x, bx = blockIdx.x;
#define PHASE_IDS const int tid = opq(threadIdx.x), lane = tid & 63; (void)tid; (void)lane
    const int vcu = (G % 8 == 0) ? (bx % 8) * (G / 8) + bx / 8 : bx;
    const int gw = vcu * NWAVES + wave, NGW = G * NWAVES;
    unsigned char* ws = args.ws;
    unsigned* ctl = (unsigned*)(ws + WS_CTL);
    for (int u = threadIdx.x; u < (LDS_BYTES - LDSCTL_OFF) / 4; u += NWAVES * 64) ((LAS unsigned*)(ldsl + LDSCTL_OFF))[u] = 0u;
    __syncthreads();
    XcdBarrier bar = xcd_barrier_post(ctl + CW_BAR, MISC + 8);

    const float* x = args.in[I_X];
    float* out = args.out;
    float* part = (float*)(ws + WS_PART); float* partc = (float*)(ws + WS_PARTC);
    float* vec = (float*)(ws + WS_VEC);
    float* rope_da = (float*)(ws + WS_ROPE_DA); float* rope_wa = (float*)(ws + WS_ROPE_WA);
    bf16_t* WupT = (bf16_t*)(ws + WS_WUP); bf16_t* WdnT = (bf16_t*)(ws + WS_WDN); bf16_t* WoutT = (bf16_t*)(ws + WS_WOUT);
    bf16_t* WodaT = (bf16_t*)(ws + WS_WODA); bf16_t* WowaT = (bf16_t*)(ws + WS_WOWA); bf16_t* WinT = (bf16_t*)(ws + WS_WIN);
    bf16_t* Hb = (bf16_t*)(ws + WS_H); bf16_t* QKV = (bf16_t*)(ws + WS_QKV); bf16_t* GATES = (bf16_t*)(ws + WS_GATES);
    float* O01 = (float*)(ws + WS_O01); float* T1 = (float*)(ws + WS_O01);
    bf16_t* Yda = (bf16_t*)(ws + WS_YDA); bf16_t* Ywa = (bf16_t*)(ws + WS_YWA);
    bf16_t* Tb = (bf16_t*)(ws + WS_T); bf16_t* H2 = (bf16_t*)(ws + WS_H2); bf16_t* D6 = (bf16_t*)(ws + WS_H);
    bf16_t* HID = (bf16_t*)(ws + WS_HID); float* EDG = (float*)(ws + WS_EDGE);

    {
        PHASE_IDS;
        LAS float* sc_ = (LAS float*)ldsl; LAS float* scc_ = sc_ + DM;
        for (int i = tid; i < DM; i += NWAVES * 64) { sc_[i] = silu_f(args.in[I_C][i]); scc_[i] = silu_f(args.in[I_CCTX][i]); }
        __syncthreads();
        const float* wada = args.in[I_WADA];
        for (int item = gw; item < 96 * 16; item += NGW) {
            const int cg = item % 96, kc = item / 96, n0 = 256 * cg + 4 * lane; const bool isctx = cg < 32;
            f32x4 a0 = {0.f, 0.f, 0.f, 0.f}, a1 = {0.f, 0.f, 0.f, 0.f};
            const float* wp = wada + (size_t)(256 * kc) * NADA + n0;
            for (int k = 0; k < 256; k += 8) {
                f32x4 w[8];
#pragma unroll
                for (int j = 0; j < 8; ++j) w[j] = __builtin_nontemporal_load((const GAS f32x4*)(wp + (size_t)(k + j) * NADA));
#pragma unroll
                for (int j = 0; j < 8; ++j) { const float s = sc_[256 * kc + k + j]; a0 += w[j] * s; if (isctx) { const float s2 = scc_[256 * kc + k + j]; a1 += w[j] * s2; } }
            }
            *(f32x4*)(part + (size_t)kc * NADA + n0) = a0;
            if (isctx) *(f32x4*)(partc + (size_t)kc * 8192 + n0) = a1;
        }
        for (int i = bx * (NWAVES * 64) + tid; i < 256 * 48; i += G * NWAVES * 64) {
            const int pos = i / 48, f = i % 48; const bool da = f < 16; const int fi = da ? f : f - 16;
            const float freq = __builtin_amdgcn_exp2f(-(float)fi * (da ? (1.f / 16.f) : (1.f / 32.f)) * 13.287712379549449f);
            const float ang = (float)pos * freq; float rev = ang * 0.15915494309189535f; rev = rev - floorf(rev);
            const float cs = __builtin_amdgcn_cosf(rev), sn = __builtin_amdgcn_sinf(rev);
            if (da) { rope_da[pos * 16 + fi] = cs; rope_da[256 * 16 + pos * 16 + fi] = sn; }
            else { rope_wa[pos * 32 + fi] = cs; rope_wa[256 * 32 + pos * 32 + fi] = sn; }
        }
        __syncthreads();
        LAS float* scr = (LAS float*)(ldsl + wave * 16384);
        constexpr int I_IN = 64 * 544, I_ODA = 32 * 128, I_OWA = 32 * 128, I_OUT = 64 * 128, I_UP = 64 * 688, I_DN = 172 * 128;
        constexpr int NITEMS = I_IN + I_UP;
        for (int it = gw; it < NITEMS; it += NGW) {
            int r = it;
            if (r < I_IN) { const int kb = r / 544, nb = r % 544; transpose_item(args.in[I_WIN], DM, NIN, WinT, 64 * kb, 32 * nb, 32 * nb, scr, lane); continue; } r -= I_IN;
            if (r < I_UP) { const int kb = r / 688, nb = r % 688; const int n0 = 32 * nb; const bool isu = n0 >= DFF; const int j0 = isu ? n0 - DFF : n0;
                const int orow0 = (j0 >> 7) * 256 + (isu ? 128 : 0) + (j0 & 127);
                transpose_item<true>(args.in[I_WUP], DM, NUP, WupT, 64 * kb, n0, orow0, scr, lane); }
        }
    }
    xcd_barrier(bar);

    {
        PHASE_IDS;
        const float* bada = args.in[I_BADA];
        for (int d = bx * (NWAVES * 64) + tid; d < DM; d += G * NWAVES * 64) {
            float m[6], mc[2];
#pragma unroll
            for (int q = 0; q < 6; ++q) { float s = bada[q * DM + d]; for (int kc = 0; kc < 16; ++kc) s += part[(size_t)kc * NADA + q * DM + d]; m[q] = s; }
#pragma unroll
            for (int q = 0; q < 2; ++q) { float s = bada[q * DM + d]; for (int kc = 0; kc < 16; ++kc) s += partc[(size_t)kc * 8192 + q * DM + d]; mc[q] = s; }
            const float ag = args.in[I_ANG][d], fg = args.in[I_FNG][d];
            vec[V_A1 * DM + d] = ag * (1.f + m[1]); vec[V_B1 * DM + d] = m[0];
            vec[V_A1C * DM + d] = ag * (1.f + mc[1]); vec[V_B1C * DM + d] = mc[0];
            vec[V_G1 * DM + d] = m[2];
            vec[V_A2 * DM + d] = fg * (1.f + m[4]); vec[V_B2 * DM + d] = m[3];
            vec[V_G2 * DM + d] = m[5];
        }
    }
    xcd_barrier(bar);

    { PHASE_IDS;
    for (int m = gw; m < MR; m += NGW) {
        const bool isl = m < SEQ;
        const float* src = isl ? x + (size_t)m * DM : args.in[I_CTX] + (size_t)(m - SEQ) * DM;
        rms_mod_row(src, vec + (isl ? V_A1 : V_A1C) * DM, vec + (isl ? V_B1 : V_B1C) * DM, Hb + (size_t)m * DM, lane);
    } }
    xcd_barrier(bar);

    {
        pg8::Gemm g{Hb, WinT, SEQ, NIN, DM}; pg8::StaticOrder S; S.init(SEQ, NIN, G, bx);
        pg8::EpiInProj E{QKV, GATES, args.in[I_BGATE]};
        pg8::gemm_phase<pg8::EpiInProj, pg8::StaticOrder, false, true>(ldsl, g, S, E);
    }
    xcd_barrier(bar);

    {
#define QK_PIECE(row, col, kind) do { \
            const bool isl_ = (row) < SEQ; \
            bf16_t* p_ = QKV + (size_t)(row) * NQKV + (col); \
            const u32x4 raw = *(const GAS u32x4*)p_; \
            float v[8] = {bf_lo(raw.x), bf_hi(raw.x), bf_lo(raw.y), bf_hi(raw.y), bf_lo(raw.z), bf_hi(raw.z), bf_lo(raw.w), bf_hi(raw.w)}; \
            float ss = 0.f; \
            _Pragma("unroll") for (int j = 0; j < 8; ++j) ss += v[j] * v[j]; \
            const bool wa = (kind) >= 2; \
            ss += shx(ss, 1, lane); ss += shx(ss, 2, lane); ss += shx(ss, 4, lane); \
            const float ss16 = ss + shx(ss, 8, lane); \
            const int hd = wa ? 128 : 64; \
            const float rstd = 1.0f / sqrtf((wa ? ss16 : ss) * (1.f / hd) + EPS); \
            const int d0 = (col) & (hd - 1);                      \
            const float* gsrc = args.in[(kind) == 0 ? I_DAQG : (kind) == 1 ? I_DAKG : (kind) == 2 ? I_WAQG : I_WAKG] + d0; \
            const f32x4 g0 = *(const f32x4*)gsrc, g1 = *(const f32x4*)(gsrc + 4); \
            const float gg[8] = {g0.x, g0.y, g0.z, g0.w, g1.x, g1.y, g1.z, g1.w}; \
            _Pragma("unroll") for (int j = 0; j < 8; ++j) v[j] = v[j] * rstd * gg[j]; \
            if (isl_) {   \
                const int qd = hd / 4; \
                const int axis = d0 / (hd / 2), idx = d0 % (hd / 2); const bool second = idx >= qd; const int fi = idx % qd; \
                const int pos = axis == 0 ? ((row) >> 6) : ((row) & 63); \
                const float* tab = wa ? rope_wa : rope_da; \
                const float* cp = tab + pos * qd + fi; const float* sp = tab + 256 * qd + pos * qd + fi; \
                const f32x4 c0 = *(const f32x4*)cp, c1 = *(const f32x4*)(cp + 4), s0 = *(const f32x4*)sp, s1 = *(const f32x4*)(sp + 4); \
                const float cc[8] = {c0.x, c0.y, c0.z, c0.w, c1.x, c1.y, c1.z, c1.w}, sn[8] = {s0.x, s0.y, s0.z, s0.w, s1.x, s1.y, s1.z, s1.w}; \
                const int pl = wa ? 4 : 2;                                 \
                _Pragma("unroll") for (int j = 0; j < 8; ++j) { const float other = shx(v[j], pl, lane); \
                    v[j] = second ? (v[j] * cc[j] + other * sn[j]) : (v[j] * cc[j] - other * sn[j]); } \
            } \
            const float qs = (kind) == 0 ? DA_C : (kind) == 2 ? WA_C : 1.0f; \
            u32x4 w; w.x = cvt_pk_bf16(v[0] * qs, v[1] * qs); w.y = cvt_pk_bf16(v[2] * qs, v[3] * qs); w.z = cvt_pk_bf16(v[4] * qs, v[5] * qs); w.w = cvt_pk_bf16(v[6] * qs, v[7] * qs); \
            *(GAS u32x4*)p_ = w; } while (0)
        constexpr int NCTXT = 20;
        if (bx < NCTXT) {
            const int pn = bx < 16 ? 8 + bx : 32 + (bx - 16);
            { pg8::Gemm g{Hb, WinT, MR, NIN, DM}; pg8::SingleOrder S{SEQ / 256, pn};
              pg8::EpiInProj E{QKV, GATES, args.in[I_BGATE]};
              pg8::gemm_phase<pg8::EpiInProj, pg8::SingleOrder, true, true>(ldsl, g, S, E); }
            const bool isk = (pn < 16) || (pn == 32) || (pn == 33);
            if (isk) {
                VM_WAIT(); __syncthreads();
                PHASE_IDS;
                const int kind = pn < 16 ? 1 : 3, col = pn * 256 + 8 * (lane & 31);
                const bool wa = kind == 3; const int hd = wa ? 128 : 64;
                const float* gsrc = args.in[wa ? I_WAKG : I_DAKG] + (col & (hd - 1));
                const f32x4 g0 = *(const f32x4*)gsrc, g1 = *(const f32x4*)(gsrc + 4);
                const float gg[8] = {g0.x, g0.y, g0.z, g0.w, g1.x, g1.y, g1.z, g1.w};
                u32x4 raw[16];
#pragma unroll
                for (int i = 0; i < 16; ++i) raw[i] = *(const GAS u32x4*)(QKV + (size_t)(SEQ + 32 * wave + 2 * i + (lane >> 5)) * NQKV + col);
                float ssv[16];
#pragma unroll
                for (int i = 0; i < 16; ++i) { const float v[8] = {bf_lo(raw[i].x), bf_hi(raw[i].x), bf_lo(raw[i].y), bf_hi(raw[i].y), bf_lo(raw[i].z), bf_hi(raw[i].z), bf_lo(raw[i].w), bf_hi(raw[i].w)};
                    float ss = 0.f;
#pragma unroll
                    for (int j = 0; j < 8; ++j) ss += v[j] * v[j];
                    ssv[i] = ss; }
#pragma unroll
                for (int m = 1; m < 8; m <<= 1)
#pragma unroll
                    for (int i = 0; i < 16; ++i) ssv[i] += shx(ssv[i], m, lane);
                if (wa) {
#pragma unroll
                    for (int i = 0; i < 16; ++i) ssv[i] += shx(ssv[i], 8, lane); }
#pragma unroll
                for (int i = 0; i < 16; ++i) { const float rstd = 1.0f / sqrtf(ssv[i] * (1.f / hd) + EPS);
                    float v[8] = {bf_lo(raw[i].x), bf_hi(raw[i].x), bf_lo(raw[i].y), bf_hi(raw[i].y), bf_lo(raw[i].z), bf_hi(raw[i].z), bf_lo(raw[i].w), bf_hi(raw[i].w)};
#pragma unroll
                    for (int j = 0; j < 8; ++j) v[j] = v[j] * rstd * gg[j];
                    u32x4 w; w.x = cvt_pk_bf16(v[0], v[1]); w.y = cvt_pk_bf16(v[2], v[3]); w.z = cvt_pk_bf16(v[4], v[5]); w.w = cvt_pk_bf16(v[6], v[7]);
                    *(GAS u32x4*)(QKV + (size_t)(SEQ + 32 * wave + 2 * i + (lane >> 5)) * NQKV + col) = w; }
            }
        } else if (G > NCTXT) {
            PHASE_IDS;
            const int gw2 = (bx - NCTXT) * NWAVES + wave, NGW2 = (G - NCTXT) * NWAVES;
            for (int it = gw2; it < SEQ * 5; it += NGW2) {
                const int row = it / 5, c = it % 5;
                int col; int kind;
                if (c < 4) { col = 2048 + 512 * c + 8 * lane; kind = 1; } else { col = OFF_KW + 8 * lane; kind = 3; }
                QK_PIECE(row, col, kind);
            }
            LAS float* scr = (LAS float*)(ldsl + wave * 16384);
            constexpr int I_ODA = 32 * 128, I_OWA = 32 * 128, I_OUT = 64 * 128;
            for (int it = gw2; it < I_ODA + I_OWA + I_OUT; it += NGW2) {
                int r = it;
                if (r < I_ODA) { const int kb = r / 128, nb = r % 128; transpose_item<true>(args.in[I_WODA], 2048, DM, WodaT, 64 * kb, 32 * nb, 32 * nb, scr, lane, DM, 0); continue; } r -= I_ODA;
                if (r < I_OWA) { const int kb = r / 128, nb = r % 128; transpose_item<true>(args.in[I_WOWA], 2048, DM, WodaT, 64 * kb, 32 * nb, 32 * nb, scr, lane, DM, 2048); continue; } r -= I_OWA;
                { const int kb = r / 128, nb = r % 128; transpose_item<true>(args.in[I_WOUT], DM, DM, WoutT, 64 * kb, 32 * nb, 32 * nb, scr, lane); }
            }
        }
#undef QK_PIECE
    }
    xcd_barrier(bar);

    {
        PHASE_IDS;
        const float mda = __uint_as_float(__builtin_amdgcn_readfirstlane(__float_as_uint(8.0f * max_abs64(args.in[I_DAQG], 64, lane) * max_abs64(args.in[I_DAKG], 64, lane))));
        float lam;
        { const float a = args.in[I_LQ1][lane] * args.in[I_LK1][lane], b = args.in[I_LQ2][lane] * args.in[I_LK2][lane];
          lam = __uint_as_float(__builtin_amdgcn_readfirstlane(__float_as_uint(__expf(wave_sum(a, lane)) - __expf(wave_sum(b, lane)) + 0.2f))); }
        for (int t = bx; t < 2048; t += G) {
            const int xq = t & 7, j = (t >> 3) & 31, i = t >> 8;
            const int h = 2 * xq + (i >> 2), mp = (i >> 1) & 1, qb = (i & 1) * 32 + j;
            const bf16_t* Qb = QKV + (size_t)(qb * 256) * NQKV + (2 * h + mp) * 64;
            const bf16_t* Kh = QKV + OFF_KA + (2 * h + mp) * 64;
            const bf16_t* Vh = QKV + OFF_VA + h * 128;
            float* Of = O01 + (size_t)(qb * 256) * 2048 + h * 128;
            att::attn_unit<false>(Qb, Kh, Vh, Of, nullptr, 2048, MR / 64, 0, MR / 64, qb * 256, -mda * LOG2E, 0.f, (char*)lds, args.in[I_DAQG], rope_da, DA_C,
                                  mp == 1, lam, args.in[I_SUBG], Yda + (size_t)(qb * 256) * DM + h * 128, DM);
        }
        const int lane2 = opq(threadIdx.x) & 63;
        const float mwa = __uint_as_float(__builtin_amdgcn_readfirstlane(__float_as_uint(11.313708498984761f * max_abs64(args.in[I_WAQG], 128, lane2) * max_abs64(args.in[I_WAKG], 128, lane2))));
        for (int t = bx; t < 1024; t += G) {
            const int xq = t & 7, kvh = xq >> 1, rb = (xq & 1) * 128 + (t >> 3);
            const int q0 = rb * 64, hq = 4 * kvh + (wave >> 1);
            const int ks = q0 - 128 < 0 ? 0 : q0 - 128; const int ke = q0 + 192 > SEQ ? SEQ : q0 + 192; const int nb = (ke - ks) / 64;
            const float sink = args.in[I_SINK][hq];
            const float mh = fmaxf(mwa, sink);
            const bf16_t* Qb = QKV + (size_t)q0 * NQKV + OFF_QW + kvh * 512;
            const bf16_t* Kh = QKV + OFF_KW + kvh * 128;
            const bf16_t* Vh = QKV + OFF_VW + kvh * 128;
            bf16_t* Ob = Yda + (size_t)q0 * DM + 2048 + kvh * 512;
            att::attn_unit<true>(Qb, Kh, Vh, nullptr, Ob, DM, nb + CTX / 64, ks, nb, q0, -mh * LOG2E, __builtin_amdgcn_exp2f((sink - mh) * LOG2E), (char*)lds, args.in[I_WAQG], rope_wa, WA_C);
        }
    }
    xcd_barrier(bar);

    {
        pg8::Gemm g{Yda, WodaT, SEQ, DM, DM}; pg8::StaticOrder S; S.init(SEQ, DM, G, bx);
        pg8::EpiMerge E{Tb, GATES, 32};
        pg8::gemm_phase<pg8::EpiMerge, pg8::StaticOrder, false, true>(ldsl, g, S, E);
    }
    xcd_barrier(bar);
    {
        pg8::Gemm g{Tb, WoutT, SEQ, DM, DM}; pg8::StaticOrder S; S.init(SEQ, DM, G, bx);
        pg8::EpiScaleBf16 E{D6, vec + V_G1 * DM};
        pg8::gemm_phase<pg8::EpiScaleBf16, pg8::StaticOrder, false, true>(ldsl, g, S, E);
    }
    xcd_barrier(bar);
    { PHASE_IDS; for (int m = gw; m < SEQ; m += NGW) rms_mod_row(x + (size_t)m * DM, vec + V_A2 * DM, vec + V_B2 * DM, H2 + (size_t)m * DM, lane, D6 + (size_t)m * DM, out + (size_t)m * DM); }
    xcd_barrier(bar);
    {
        pg8::Gemm g{H2, WupT, SEQ, NUP, DM}; pg8::StaticOrder S; S.init(SEQ, NUP, G, bx);
        pg8::EpiUpConv E{HID, EDG, EDG + EDGE_ELEMS, EDG + 2 * EDGE_ELEMS, args.in[I_CONVW], args.in[I_CONVB], ldsl};
        pg8::gemm_phase<pg8::EpiUpConv, pg8::StaticOrder, true, true>(ldsl, g, S, E);
        const int nshort = G - (64 * 86) % G;
        if ((64 * 86) % G != 0 ? bx >= G - nshort : true) {
            PHASE_IDS;
            LAS float* scr = (LAS float*)(ldsl + wave * 16384);
            const int first = (64 * 86) % G != 0 ? G - nshort : 0, nconv = (64 * 86) % G != 0 ? nshort : G;
            for (int r = (bx - first) * NWAVES + wave; r < 172 * 128; r += nconv * NWAVES) { const int kb = r / 128, nb = r % 128; transpose_item(args.in[I_WDN], DFF, DM, WdnT, 64 * kb, 32 * nb, 32 * nb, scr, lane); }
        }
    }
    xcd_barrier(bar);
    {
        PHASE_IDS;
        const float* cw = args.in[I_CONVW];
        const float* EA = EDG; const float* EP = EDG + EDGE_ELEMS; const float* EU = EDG + 2 * EDGE_ELEMS;
        constexpr int NCH = DFF / 4;
        for (int it = bx * (NWAVES * 64) + tid; it < 128 * NCH; it += G * NWAVES * 64) {
            const int er = it / NCH, c = 4 * (it % NCH); const int pm = er >> 1, e = er & 1;
            const size_t row = (size_t)pm * 256 + (e ? 255 : 0);
            const f32x4 part = *(const GAS f32x4*)(EP + (size_t)er * DFF + c), uu = *(const GAS f32x4*)(EU + (size_t)er * DFF + c);
            f32x4 an = {0.f, 0.f, 0.f, 0.f};
            if (e == 0 && pm > 0) an = *(const GAS f32x4*)(EA + ((size_t)(pm - 1) * 2 + 1) * DFF + c);
            if (e == 1 && pm < 63) an = *(const GAS f32x4*)(EA + ((size_t)(pm + 1) * 2 + 0) * DFF + c);
            const f32x4 wm = *(const GAS f32x4*)(cw + (e ? 2 * DFF : 0) + c);
            const f32x4 cv = part + wm * an; f32x4 hv;
#pragma unroll
            for (int j = 0; j < 4; ++j) hv[j] = cv[j] * __builtin_amdgcn_rcpf(1.0f + __builtin_amdgcn_exp2f(-cv[j] * LOG2E)) * uu[j];
            u32x2 w; w.x = cvt_pk_bf16(hv[0], hv[1]); w.y = cvt_pk_bf16(hv[2], hv[3]);
            *(GAS u32x2*)(HID + row * DFF + c) = w;
        }
    }
    xcd_barrier(bar);
    {
        pg8::Gemm g{HID, WdnT, SEQ, DM, DFF}; pg8::StaticOrder S; S.init(SEQ, DM, G, bx, 2);
        pg8::EpiResid E{out, out, vec + V_G2 * DM};
        pg8::gemm_phase<pg8::EpiResid, pg8::StaticOrder, false, true>(ldsl, g, S, E);
    }
    if (xb_ld(ctl + CW_BAR + XB_TMO) != 0u) {
        VM_WAIT(); __syncthreads();
        const float qn = __builtin_nanf("");
        for (size_t i = (size_t)bx * (NWAVES * 64) + threadIdx.x; i < (size_t)SEQ * DM / 4; i += (size_t)G * NWAVES * 64) ((f32x4*)out)[i] = (f32x4){qn, qn, qn, qn};
    }
}

extern "C" void kernel_launch(void* const* d_in, const int* in_sizes, int n_in, void* d_out, int out_size, void* d_ws, size_t ws_size, hipStream_t stream) {
    static int grid = 0;
    if (grid == 0) {
        if (n_in != 27 || out_size != SEQ * DM || ws_size < WS_END) { fprintf(stderr, "kernel_launch: unexpected shapes (n_in %d out %d ws %zu need %zu)\n", n_in, out_size, ws_size, (size_t)WS_END); grid = -1; return; }
        int dev = 0, cus = 0, per_cu = 0;
        if (hipGetDevice(&dev) != hipSuccess || hipDeviceGetAttribute(&cus, hipDeviceAttributeMultiprocessorCount, dev) != hipSuccess) { grid = -1; return; }
        if (hipFuncSetAttribute((const void*)fwd_kernel, hipFuncAttributeMaxDynamicSharedMemorySize, LDS_BYTES) != hipSuccess) { fprintf(stderr, "kernel_launch: hipFuncSetAttribute failed\n"); grid = -1; return; }
        if (hipOccupancyMaxActiveBlocksPerMultiprocessor(&per_cu, (const void*)fwd_kernel, NWAVES * 64, LDS_BYTES) != hipSuccess || per_cu < 1)
            fprintf(stderr, "kernel_launch: occupancy query reports %d workgroups per CU\n", per_cu);
        (void)hipGetLastError();
        grid = cus;
        if (512 % grid != 0) { fprintf(stderr, "kernel_launch: %d CUs: this build pairs the two maps of a differential-attention head through a 512 %% grid == 0 unit deal; nothing launched\n", grid); grid = -1; return; }
    }
    if (grid < 0) return;
    if (hipMemsetAsync((char*)d_ws + WS_CTL, 0, CTL_ZERO_BYTES, stream) != hipSuccess) { fprintf(stderr, "kernel_launch: memset failed\n"); return; }
    Args a{};
    for (int i = 0; i < 27; ++i) a.in[i] = (const float*)d_in[i];
    a.out = (float*)d_out; a.ws = (unsigned char*)d_ws;
    hipLaunchKernelGGL(fwd_kernel, dim3(grid), dim3(NWAVES * 64), LDS_BYTES, stream, a);
    const hipError_t le = hipPeekAtLastError();
    if (le != hipSuccess) fprintf(stderr, "kernel_launch: launch failed: %s\n", hipGetErrorName(le));
}
```
